# Optimizing an MI355X kernel written in HIP

```python
import math
import jax, jax.numpy as jnp
from jax import lax
import numpy as np

D_MODEL = 1024
BATCH = 16
SEQ = 256
DEPTH = 2
DEC_BATCH = 2
DEC_SEQ = 4096
PAST_LEN = 256

GRID_W = 64
H_A = 4
DK_A = 64
DV_A = 128
RET_CHUNK = 128
H_B = 4
DK_B = 64
DV_B = 128
GLA_CHUNK = 16
GLA_RANK = 16
GLA_TAU = 16.0
H_C = 4
DH_C = 64
Q_BLOCK = 128
D_FF = 2816
CONV_W = 3
ROPE_BASE = 10000.0
N_BRANCH = 3
BRANCH_W = 512
ALPHA = (2 * DEPTH) ** 0.25
BETA = (8 * DEPTH) ** -0.25
EPS = 1e-5
SPLIT_SIZES = (H_A * DK_A, H_A * DK_A, H_A * DV_A, H_A * DV_A,
               H_B * DK_B, H_B * DK_B, H_B * DV_B, H_B * DV_B,
               2 * H_C * DH_C, 2 * H_C * DH_C, 2 * H_C * DH_C,
               D_MODEL, D_MODEL, D_MODEL)
D_IN = sum(SPLIT_SIZES)

kernel_name = 'hybrid_ret_gla_diffattn_prefix_dit_step'


def _normalize(x):
    xf = x.astype(jnp.float32)
    mu = xf.mean(-1, keepdims=True)
    var = jnp.square(xf - mu).mean(-1, keepdims=True)
    return (xf - mu) * lax.rsqrt(var + EPS)


def layer_norm(x, g, b):
    return (_normalize(x) * g + b).astype(x.dtype)


def rms_norm(x, g):
    xf = x.astype(jnp.float32)
    return (xf * lax.rsqrt(jnp.mean(xf * xf, -1, keepdims=True) + EPS) * g).astype(x.dtype)


def heads(x, g):
    B, T, _ = x.shape
    return x.reshape(B, T, g, -1).transpose(0, 2, 1, 3)


def merge_heads(x):
    B, G, T, d = x.shape
    return x.transpose(0, 2, 1, 3).reshape(B, T, G * d)


def rev(x):
    return jnp.flip(x, axis=2)


def grid_positions(T):
    rows = T // GRID_W
    row = jnp.repeat(jnp.arange(rows, dtype=jnp.float32), GRID_W)
    col = (jnp.arange(T) % GRID_W).astype(jnp.float32)
    return row, col


def rope_1d(x, p):
    half = x.shape[-1] // 2
    inv = ROPE_BASE ** (-jnp.arange(half, dtype=jnp.float32) / half)
    ang = p[:, None] * inv[None, :]
    cos, sin = jnp.cos(ang), jnp.sin(ang)
    x1, x2 = x[..., :half], x[..., half:]
    return jnp.concatenate([x1 * cos - x2 * sin, x2 * cos + x1 * sin], axis=-1)


def rope_2d(x, pos):
    row, col = pos
    d = x.shape[-1] // 2
    xf = x.astype(jnp.float32)
    return jnp.concatenate([rope_1d(xf[..., :d], row), rope_1d(xf[..., d:], col)], axis=-1).astype(x.dtype)


def chunk_state_scan(q_dec, k_dec, v, chunk_decay, s0):
    delta = jnp.einsum('bgnck,bgncv->bgnkv', k_dec, v)

    def step(s, inp):
        dec, d = inp
        return dec[..., None] * s + d, s

    s_final, s_before = lax.scan(step, s0.astype(jnp.float32),
                                 (jnp.moveaxis(chunk_decay, 2, 0), jnp.moveaxis(delta, 2, 0)))
    s_before = jnp.moveaxis(s_before, 0, 2)
    inter = jnp.einsum('bgnck,bgnkv->bgncv', q_dec, s_before)
    return inter, s_final


def retention_dir(q, k, v, log_gamma, s0):
    B, H, T, _ = q.shape
    C = RET_CHUNK
    n = T // C
    qc = q.reshape(B, H, n, C, -1)
    kc = k.reshape(B, H, n, C, -1)
    vc = v.reshape(B, H, n, C, -1)
    idx = jnp.arange(C, dtype=jnp.float32)
    lg = log_gamma[:, None]
    b = (idx + 1.0)[None, :] * lg
    diff = idx[:, None] - idx[None, :]
    dmat = jnp.where(diff >= 0, jnp.exp(jnp.maximum(diff, 0.0)[None] * lg[:, :, None]), 0.0)
    scores = jnp.einsum('bhnik,bhnjk->bhnij', qc, kc) * dmat[None, :, None]
    intra = jnp.einsum('bhnij,bhnjv->bhniv', scores, vc)
    q_dec = qc * jnp.exp(b)[None, :, None, :, None]
    k_dec = kc * jnp.exp(C * lg - b)[None, :, None, :, None]
    chunk_decay = jnp.broadcast_to(jnp.exp(C * lg)[None, :, None, :], (B, H, n, qc.shape[-1]))
    inter, s_final = chunk_state_scan(q_dec, k_dec, vc, chunk_decay, s0)
    return (intra + inter).reshape(B, H, T, -1), s_final


def gla_dir(q, k, v, log_a, s0):
    B, H, T, _ = q.shape
    C = GLA_CHUNK
    n = T // C
    qc = q.reshape(B, H, n, C, -1)
    kc = k.reshape(B, H, n, C, -1)
    vc = v.reshape(B, H, n, C, -1)
    b = jnp.cumsum(log_a.reshape(B, H, n, C, -1), axis=3)
    b_last = b[:, :, :, -1:, :]
    causal = jnp.tril(jnp.ones((C, C), dtype=bool))
    pair = jnp.where(causal[:, :, None], b[:, :, :, :, None, :] - b[:, :, :, None, :, :], -jnp.inf)
    attn = jnp.einsum('bhntk,bhnsk,bhntsk->bhnts', qc, kc, jnp.exp(pair))
    intra = jnp.einsum('bhnts,bhnsv->bhntv', attn, vc)
    q_dec = qc * jnp.exp(b)
    k_dec = kc * jnp.exp(b_last - b)
    inter, s_final = chunk_state_scan(q_dec, k_dec, vc, jnp.exp(b_last[:, :, :, 0]), s0)
    return (intra + inter).reshape(B, H, T, -1), s_final


def diff_attention(q, k, v, lam, lam_init, subln_g):
    B, G, Tq, dh = q.shape
    nb = Tq // Q_BLOCK
    qb = jnp.moveaxis(q.reshape(B, G, nb, Q_BLOCK, dh), 2, 0)
    scale = dh ** -0.5

    def block(qi):
        s = jnp.einsum('bgqd,bgkd->bgqk', qi, k).astype(jnp.float32) * scale
        p = jax.nn.softmax(s, axis=-1).reshape(B, H_C, 2, Q_BLOCK, -1)
        a = (p[:, :, 0] - lam * p[:, :, 1]).astype(v.dtype)
        return jnp.einsum('bhqk,bhkv->bhqv', a, v)

    o = lax.map(block, qb)
    o = jnp.moveaxis(o, 0, 2).reshape(B, H_C, Tq, -1)
    o = rms_norm(o, subln_g) * (1.0 - lam_init)
    return merge_heads(o)


def token_mixer(h, l, P, pos, ctx):
    B, T, _ = h.shape
    f32 = jnp.float32
    dt = h.dtype
    points = np.cumsum(SPLIT_SIZES)[:-1].tolist()
    (a_q, a_k, a_v, a_g, b_q, b_k, b_v, b_r, c_q, c_k, c_v,
     m_a, m_b, m_c) = jnp.split(h @ P['w_in'][l], points, axis=-1)

    q = heads(a_q, H_A).astype(f32)
    k = heads(a_k, H_A).astype(f32) * DK_A ** -0.5
    if pos is not None:
        q, k = rope_2d(q, pos), rope_2d(k, pos)
    v = heads(a_v, H_A).astype(f32)
    s0 = jnp.zeros((B, 2, H_A, DK_A, DV_A), f32) if ctx is None else ctx['ret'].astype(f32)
    lg = jax.nn.log_sigmoid(P['ret_decay'][l].astype(f32))
    ya_f, sa_f = retention_dir(q, k, v, lg[0], s0[:, 0])
    ya_b, sa_b = retention_dir(rev(q), rev(k), rev(v), lg[1], s0[:, 1])
    y_a = merge_heads(_normalize(ya_f + rev(ya_b))) * jax.nn.silu(a_g.astype(f32))
    ret_state = jnp.stack([sa_f, sa_b], axis=1)

    q = heads(b_q, H_B).astype(f32) * DK_B ** -0.5
    k = heads(b_k, H_B).astype(f32)
    v = heads(b_v, H_B).astype(f32)

    def log_gate(e):
        z = (h @ P['gla_wa1'][l, e]) @ P['gla_wa2'][l, e] + P['gla_ba'][l, e]
        return heads(jax.nn.log_sigmoid(z.astype(f32)) / GLA_TAU, H_B)

    s0 = jnp.zeros((B, 2, H_B, DK_B, DV_B), f32) if ctx is None else ctx['gla'].astype(f32)
    yb_f, sb_f = gla_dir(q, k, v, log_gate(0), s0[:, 0])
    yb_b, sb_b = gla_dir(rev(q), rev(k), rev(v), rev(log_gate(1)), s0[:, 1])
    y_b = merge_heads(rms_norm(yb_f + rev(yb_b), P['gla_norm_g'][l])) * jax.nn.silu(b_r.astype(f32))
    gla_state = jnp.stack([sb_f, sb_b], axis=1)

    cq = heads(c_q, 2 * H_C)
    ck = heads(c_k, 2 * H_C)
    cv = heads(c_v, H_C)
    if pos is not None:
        cq, ck = rope_2d(cq, pos), rope_2d(ck, pos)
    if ctx is None:
        k_all, v_all = ck, cv
    else:
        k_all = jnp.concatenate([ctx['dk'].astype(ck.dtype), ck], axis=2)
        v_all = jnp.concatenate([ctx['dv'].astype(cv.dtype), cv], axis=2)
    lam_init = 0.8 - 0.6 * math.exp(-0.3 * l)
    lp = P['diff_lam'][l].astype(f32)
    lam = jnp.exp(jnp.sum(lp[0] * lp[1])) - jnp.exp(jnp.sum(lp[2] * lp[3])) + lam_init
    y_c = diff_attention(cq, k_all, v_all, lam, lam_init, P['diff_subln_g'][l])

    wb = P['w_branch'][l]
    merged = (jax.nn.sigmoid(m_a) * (y_a.astype(dt) @ wb[0])
              + jax.nn.sigmoid(m_b) * (y_b.astype(dt) @ wb[1])
              + jax.nn.sigmoid(m_c) * (y_c.astype(dt) @ wb[2]))
    out = merged @ P['w_out'][l]
    return out, (ck, cv, ret_state.astype(dt), gla_state.astype(dt))


def conv_ffn(h, l, P):
    a, b = jnp.split(h @ P['ffn_w_up'][l], 2, axis=-1)
    w = P['ffn_conv_w'][l]
    ap = jnp.pad(a, ((0, 0), (1, 1), (0, 0)))
    a = ap[:, :-2] * w[0] + ap[:, 1:-1] * w[1] + ap[:, 2:] * w[2] + P['ffn_conv_b'][l]
    return (jax.nn.gelu(a) * b) @ P['ffn_w_down'][l]


def trunk_layer(x, cvec, l, P, pos, ctx):
    mod = jax.nn.silu(cvec) @ P['ada_w'][l] + P['ada_b'][l]
    sh1, sc1, g1, sh2, sc2, g2 = jnp.split(mod, 6, axis=-1)
    mix, ctx_out = token_mixer(x * (1.0 + sc1) + sh1, l, P, pos, ctx)
    x = layer_norm(ALPHA * x + g1 * mix, P['ln_g'][l, 0], P['ln_b'][l, 0])
    ff = conv_ffn(x * (1.0 + sc2) + sh2, l, P)
    x = layer_norm(ALPHA * x + g2 * ff, P['ln_g'][l, 1], P['ln_b'][l, 1])
    return x, ctx_out


def setup_inputs(seed: int = 0) -> dict:
    key = jax.random.key(seed)
    ks = jax.random.split(key, 26)
    f32 = jnp.float32

    def nrm(k, shape, s):
        return s * jax.random.normal(k, shape, f32)

    gam = 1.0 - 2.0 ** (-5.0 - jnp.arange(H_A, dtype=f32))
    return {
        'x_prompt': nrm(ks[0], (BATCH, SEQ, D_MODEL), 1.0),
        'x_sample': nrm(ks[1], (DEC_BATCH, DEC_SEQ, D_MODEL), 1.0),
        'cache_diff_k': nrm(ks[2], (DEC_BATCH, DEPTH, 2 * H_C, PAST_LEN, DH_C), 1.0),
        'cache_diff_v': nrm(ks[3], (DEC_BATCH, DEPTH, H_C, PAST_LEN, 2 * DH_C), 1.0),
        'state_ret': nrm(ks[4], (DEC_BATCH, DEPTH, 2, H_A, DK_A, DV_A), 0.5),
        'state_gla': nrm(ks[5], (DEC_BATCH, DEPTH, 2, H_B, DK_B, DV_B), 0.5),
        'c': nrm(ks[6], (DEC_BATCH, D_MODEL), 1.0),
        'c_ctx': nrm(ks[7], (D_MODEL,), 1.0),
        'ada_w': nrm(ks[8], (DEPTH, D_MODEL, 6 * D_MODEL), 0.5 * D_MODEL ** -0.5),
        'ada_b': nrm(ks[9], (DEPTH, 6 * D_MODEL), 0.02),
        'w_in': nrm(ks[10], (DEPTH, D_MODEL, D_IN), D_MODEL ** -0.5),
        'ret_decay': jnp.log(gam / (1.0 - gam))[None, None, :] + nrm(ks[11], (DEPTH, 2, H_A), 0.1),
        'gla_wa1': nrm(ks[12], (DEPTH, 2, D_MODEL, GLA_RANK), D_MODEL ** -0.5),
        'gla_wa2': nrm(ks[13], (DEPTH, 2, GLA_RANK, H_B * DK_B), GLA_RANK ** -0.5),
        'gla_ba': nrm(ks[14], (DEPTH, 2, H_B * DK_B), 0.1),
        'gla_norm_g': 1.0 + nrm(ks[15], (DEPTH, DV_B), 0.02),
        'diff_lam': nrm(ks[16], (DEPTH, 4, DH_C), 0.1),
        'diff_subln_g': 1.0 + nrm(ks[17], (DEPTH, 2 * DH_C), 0.02),
        'w_branch': nrm(ks[18], (DEPTH, N_BRANCH, BRANCH_W, D_MODEL), BETA * BRANCH_W ** -0.5),
        'w_out': nrm(ks[19], (DEPTH, D_MODEL, D_MODEL), BETA * D_MODEL ** -0.5),
        'ln_g': 1.0 + nrm(ks[20], (DEPTH, 2, D_MODEL), 0.02),
        'ln_b': nrm(ks[21], (DEPTH, 2, D_MODEL), 0.02),
        'ffn_w_up': nrm(ks[22], (DEPTH, D_MODEL, 2 * D_FF), BETA * D_MODEL ** -0.5),
        'ffn_conv_w': nrm(ks[23], (DEPTH, CONV_W, D_FF), CONV_W ** -0.5),
        'ffn_conv_b': nrm(ks[24], (DEPTH, D_FF), 0.02),
        'ffn_w_down': nrm(ks[25], (DEPTH, D_FF, D_MODEL), BETA * D_FF ** -0.5),
    }


def reference(x_prompt, x_sample, cache_diff_k, cache_diff_v, state_ret, state_gla, c, c_ctx,
              ada_w, ada_b, w_in, ret_decay, gla_wa1, gla_wa2, gla_ba, gla_norm_g, diff_lam,
              diff_subln_g, w_branch, w_out, ln_g, ln_b, ffn_w_up, ffn_conv_w, ffn_conv_b, ffn_w_down):
    P = {'ada_w': ada_w, 'ada_b': ada_b, 'w_in': w_in, 'ret_decay': ret_decay,
         'gla_wa1': gla_wa1, 'gla_wa2': gla_wa2, 'gla_ba': gla_ba, 'gla_norm_g': gla_norm_g,
         'diff_lam': diff_lam, 'diff_subln_g': diff_subln_g, 'w_branch': w_branch, 'w_out': w_out,
         'ln_g': ln_g, 'ln_b': ln_b, 'ffn_w_up': ffn_w_up, 'ffn_conv_w': ffn_conv_w,
         'ffn_conv_b': ffn_conv_b, 'ffn_w_down': ffn_w_down}

    h = x_prompt
    cc = c_ctx[None, None, :]
    dks, dvs, rets, glas = [], [], [], []
    for l in range(DEPTH):
        h, (dk_l, dv_l, ret_l, gla_l) = trunk_layer(h, cc, l, P, None, None)
        dks.append(dk_l)
        dvs.append(dv_l)
        rets.append(ret_l)
        glas.append(gla_l)
    y_prompt = h
    new_diff_k = jnp.stack(dks, axis=1)
    new_diff_v = jnp.stack(dvs, axis=1)
    new_state_ret = jnp.stack(rets, axis=1)
    new_state_gla = jnp.stack(glas, axis=1)

    pos = grid_positions(x_sample.shape[1])
    z = x_sample
    cs = c[:, None, :]
    for l in range(DEPTH):
        ctx = {'dk': cache_diff_k[:, l], 'dv': cache_diff_v[:, l],
               'ret': state_ret[:, l], 'gla': state_gla[:, l]}
        z, _ = trunk_layer(z, cs, l, P, pos, ctx)
    y_sample = z

    return (y_prompt, y_sample, new_diff_k, new_diff_v, new_state_ret, new_state_gla)
```

```cpp
#include <hip/hip_runtime.h>
#include <hip/hip_cooperative_groups.h>
#include <cstdio>
namespace cg = cooperative_groups;

#ifndef MULTI_LAUNCH
#define MULTI_LAUNCH 0
#endif

typedef unsigned short u16;
using bf16x8 = __attribute__((ext_vector_type(8))) short;
using s16x4  = __attribute__((ext_vector_type(4))) short;
using f32x4  = __attribute__((ext_vector_type(4))) float;
using f32x16 = __attribute__((ext_vector_type(16))) float;
#define DI __device__ __forceinline__
#define GAS __attribute__((address_space(1)))
typedef const GAS unsigned short* gcu16p;
typedef unsigned u32x4 __attribute__((ext_vector_type(4)));
typedef const GAS u32x4* gcu4p;

#define NTOK 12288
#define PLD 3584
#define ALPHA_F 1.4142135623730951f
#define EPS_F 1e-5f
#define LOG2E_F 1.4426950408889634f

#define OUT_YS   4194304
#define OUT_DK   12582912
#define OUT_DV   16777216
#define OUT_SRET 20971520
#define OUT_SGLA 23068672

#define SCAN_MIX_ELEMS 12582912
#define SCAN_SAMPLE_OFF 4194304
#define DEC_MIX 98304
#define DEC_SAMPLE_OFF 32768

struct Params {
  const float *x_prompt, *x_sample, *cache_k, *cache_v, *state_ret, *state_gla, *c, *c_ctx;
  const float *ada_w, *ada_b, *w_in, *ret_decay, *gla_wa1, *gla_wa2, *gla_ba, *gla_norm_g, *diff_lam,
      *diff_subln_g, *w_branch, *w_out, *ln_g, *ln_b, *ffn_w_up, *ffn_conv_w, *ffn_conv_b, *ffn_w_down;
  float* out;
  u16 *WinT, *WbT, *WoT, *WupT, *WdT;
  u16 *proj, *Kc_p, *VcT_p, *Kc_s, *VcT_s, *h, *scan;
  float *dec, *r, *stats, *mod, *rope, *lam;
  unsigned* bar;
};

DI int rtid() { int t = __builtin_amdgcn_workitem_id_x(); asm volatile("" : "+v"(t)); return t; }
DI int tidx() { int t = __builtin_amdgcn_workitem_id_x() & 255; asm volatile("" : "+v"(t)); return t; }
typedef __bf16 bf2_t __attribute__((ext_vector_type(2)));
typedef float f2_t __attribute__((ext_vector_type(2)));
DI unsigned pack2(float a, float b) { f2_t v = {a, b}; return __builtin_bit_cast(unsigned, __builtin_convertvector(v, bf2_t)); }
DI u16 f2bf(float x) { return (u16)(pack2(x, 0.f) & 0xffffu); }
DI float bf2f(u16 b) { return __uint_as_float(((unsigned)b) << 16); }
DI float sigmoidf_(float x) { return __builtin_amdgcn_rcpf(1.f + __expf(-x)); }
DI float siluf_(float x) { return x * __builtin_amdgcn_rcpf(1.f + __expf(-x)); }
DI float logsigf_(float z) { return fminf(z, 0.f) - __logf(1.f + __expf(-fabsf(z))); }
DI float geluf_(float x) { float y = 0.7978845608028654f * (x + 0.044715f * x * x * x); float t = 1.f - 2.f * __builtin_amdgcn_rcpf(1.f + __expf(2.f * y)); return 0.5f * x * (1.f + t); }
DI int tok_cv(int tok) { return tok < 4096 ? 0 : 1 + ((tok - 4096) >> 12); }
DI f32x4 zero4() { f32x4 z = {0.f, 0.f, 0.f, 0.f}; return z; }
#define MFMA16(a, b, c) __builtin_amdgcn_mfma_f32_16x16x32_bf16((a), (b), (c), 0, 0, 0)
#define MFMA32(a, b, c) __builtin_amdgcn_mfma_f32_32x32x16_bf16((a), (b), (c), 0, 0, 0)

struct GemmNext { const u16* A; int lda; const u16* B; int ldb; int n0; int bcs; int nbc; int m0; };
template <int MI, bool TR = false, int NJ = 4, bool PRE = false, bool NEXT = false>
DI void gemm_main(f32x4 (&acc)[MI][NJ], const u16* __restrict__ A, int lda, int m0, int mmax,
                  const u16* __restrict__ B, int ldb, int n0, int K, char* smem, int bcs = 64, GemmNext nx = GemmNext{}) {
  constexpr int NBC = MI == 8 ? 4 : (MI == 4 ? 2 : NJ / 4);
  const int tid = rtid(), lane = tid & 63, wid = tid >> 6;
  const int wro = MI == 8 ? (wid >> 2) * 128 : (MI == 4 ? (wid >> 1) * 64 : wid * 32);
  const int wco = MI == 8 ? (wid & 3) * 64 : (MI == 4 ? (wid & 1) * 64 : 0);
  const int lr = tid >> 3, lch = tid & 7;
  size_t aoff0, aoff1, aoff2, aoff3;
  { int r = m0 + lr; r = r < 0 ? 0 : (r > mmax ? mmax : r); aoff0 = (size_t)r * lda + lch * 8; }
  { int r = m0 + lr + 64; r = r < 0 ? 0 : (r > mmax ? mmax : r); aoff1 = (size_t)r * lda + lch * 8; }
  { int r = m0 + lr + 128; r = r < 0 ? 0 : (r > mmax ? mmax : r); aoff2 = (size_t)r * lda + lch * 8; }
  { int r = m0 + lr + 192; r = r < 0 ? 0 : (r > mmax ? mmax : r); aoff3 = (size_t)r * lda + lch * 8; }
  gcu16p Ag = (gcu16p)A;
  gcu16p bbase = (gcu16p)B + (size_t)(n0 + lr) * ldb + lch * 8;
  const int soff = lr * 128 + ((lch ^ ((lr >> 1) & 7)) << 4);
  const int lr16 = lane & 15, q = lane >> 4, swz = lr16 >> 1;
  const int c0 = ((q ^ swz) << 4);
  const int aro = (wro + lr16) * 128, bro = 32768 + (wco + lr16) * 128;
  u32x4 ra0, ra1, ra2, ra3, rb0, rb1, rb2, rb3;
  rb1 = (u32x4){0u, 0u, 0u, 0u}; rb2 = rb1; rb3 = rb1;
  const int nk = K >> 6;
#define G_LOAD(k0_) do { \
    ra0 = *(gcu4p)(Ag + aoff0 + (k0_)); ra1 = *(gcu4p)(Ag + aoff1 + (k0_)); \
    ra2 = *(gcu4p)(Ag + aoff2 + (k0_)); ra3 = *(gcu4p)(Ag + aoff3 + (k0_)); \
    rb0 = *(gcu4p)(bbase + (k0_)); \
    if (NBC >= 2) rb1 = *(gcu4p)(bbase + (size_t)bcs * ldb + (k0_)); \
    if (NBC >= 3) rb2 = *(gcu4p)(bbase + (size_t)(2 * bcs) * ldb + (k0_)); \
    if (NBC == 4) rb3 = *(gcu4p)(bbase + (size_t)(3 * bcs) * ldb + (k0_)); } while (0)
#define G_STORE(sw_) do { \
    *reinterpret_cast<u32x4*>((sw_) + soff) = ra0; *reinterpret_cast<u32x4*>((sw_) + soff + 8192) = ra1; \
    *reinterpret_cast<u32x4*>((sw_) + soff + 16384) = ra2; *reinterpret_cast<u32x4*>((sw_) + soff + 24576) = ra3; \
    *reinterpret_cast<u32x4*>((sw_) + 32768 + soff) = rb0; \
    if (NBC >= 2) *reinterpret_cast<u32x4*>((sw_) + 32768 + soff + 8192) = rb1; \
    if (NBC >= 3) *reinterpret_cast<u32x4*>((sw_) + 32768 + soff + 16384) = rb2; \
    if (NBC == 4) *reinterpret_cast<u32x4*>((sw_) + 32768 + soff + 24576) = rb3; } while (0)
#define LDA_(sb_, ks_, mi_) (*reinterpret_cast<const bf16x8*>((sb_) + aro + (mi_) * 2048 + (c0 ^ ((ks_) * 64))))
#define LDB_(sb_, ks_, ni_) (*reinterpret_cast<const bf16x8*>((sb_) + bro + (ni_) * 2048 + (c0 ^ ((ks_) * 64))))
#define G_SB() __builtin_amdgcn_sched_barrier(0)
#define G_STEP(sb_, s_) do { \
    if ((s_) + 3 < 16) ar[((s_) + 3) & 3] = LDA_(sb_, ((s_) + 3) >> 3, ((s_) + 3) & 7); \
    if ((s_) >= 4 && (s_) < 8) b1[((s_) - 4) & 3] = LDB_(sb_, 1, ((s_) - 4) & 3); \
    _Pragma("unroll") for (int ni = 0; ni < 4; ++ni) \
      acc[(s_) & (MI - 1)][ni] = TR ? MFMA16(((s_) >> 3) ? b1[ni] : b0[ni], ar[(s_) & 3], acc[(s_) & (MI - 1)][ni]) : MFMA16(ar[(s_) & 3], ((s_) >> 3) ? b1[ni] : b0[ni], acc[(s_) & (MI - 1)][ni]); \
    G_SB(); } while (0)
#define G_COMPUTE(sb_) do { \
    if (MI == 8) { \
      bf16x8 b0[4], b1[4], ar[4]; \
      _Pragma("unroll") for (int ni = 0; ni < 4; ++ni) b0[ni] = LDB_(sb_, 0, ni); \
      ar[0] = LDA_(sb_, 0, 0); ar[1] = LDA_(sb_, 0, 1); ar[2] = LDA_(sb_, 0, 2); \
      G_SB(); \
      G_STEP(sb_, 0); G_STEP(sb_, 1); G_STEP(sb_, 2); G_STEP(sb_, 3); G_STEP(sb_, 4); G_STEP(sb_, 5); G_STEP(sb_, 6); G_STEP(sb_, 7); \
      G_STEP(sb_, 8); G_STEP(sb_, 9); G_STEP(sb_, 10); G_STEP(sb_, 11); G_STEP(sb_, 12); G_STEP(sb_, 13); G_STEP(sb_, 14); G_STEP(sb_, 15); \
    } else if (NJ != 4) { \
      _Pragma("unroll") for (int ks = 0; ks < 2; ++ks) { \
        bf16x8 af2[MI]; \
        _Pragma("unroll") for (int mi = 0; mi < MI; ++mi) af2[mi] = LDA_(sb_, ks, mi); \
        _Pragma("unroll") for (int ni = 0; ni < NJ; ++ni) { \
          const bf16x8 bq = LDB_(sb_, ks, ni); \
          _Pragma("unroll") for (int mi = 0; mi < MI; ++mi) acc[mi][ni] = MFMA16(af2[mi], bq, acc[mi][ni]); } } \
    } else { \
      _Pragma("unroll") for (int ks = 0; ks < 2; ++ks) { \
        bf16x8 af[MI], bfr[4]; \
        _Pragma("unroll") for (int mi = 0; mi < MI; ++mi) af[mi] = LDA_(sb_, ks, mi); \
        _Pragma("unroll") for (int ni = 0; ni < 4; ++ni) bfr[ni] = LDB_(sb_, ks, ni); \
        _Pragma("unroll") for (int mi = 0; mi < MI; ++mi) \
          _Pragma("unroll") for (int ni = 0; ni < 4; ++ni) acc[mi][ni] = TR ? MFMA16(bfr[ni], af[mi], acc[mi][ni]) : MFMA16(af[mi], bfr[ni], acc[mi][ni]); } \
    } } while (0)
#define G_BAR() asm volatile("s_waitcnt lgkmcnt(0)\n\ts_barrier" ::: "memory")
  const int klast = K - 64;
#ifndef NO_GLDS
  {
    const int sw8 = ((lch ^ ((lr >> 1) & 7)) - lch) * 8;
    typedef __attribute__((address_space(3))) unsigned* ldsu;
    ldsu lbase = (ldsu)(smem) + wid * 256;
#define G_DMA(stage_, k0_) do { \
      ldsu lb_ = lbase + (stage_) * 16384; \
      __builtin_amdgcn_global_load_lds((const GAS unsigned*)(Ag + aoff0 + sw8 + (k0_)), lb_, 16, 0, 0); \
      __builtin_amdgcn_global_load_lds((const GAS unsigned*)(Ag + aoff1 + sw8 + (k0_)), lb_ + 2048, 16, 0, 0); \
      __builtin_amdgcn_global_load_lds((const GAS unsigned*)(Ag + aoff2 + sw8 + (k0_)), lb_ + 4096, 16, 0, 0); \
      __builtin_amdgcn_global_load_lds((const GAS unsigned*)(Ag + aoff3 + sw8 + (k0_)), lb_ + 6144, 16, 0, 0); \
      __builtin_amdgcn_global_load_lds((const GAS unsigned*)(bbase + sw8 + (k0_)), lb_ + 8192, 16, 0, 0); \
      if (NBC >= 2) __builtin_amdgcn_global_load_lds((const GAS unsigned*)(bbase + (size_t)bcs * ldb + sw8 + (k0_)), lb_ + 8192 + 2048, 16, 0, 0); \
      if (NBC >= 3) __builtin_amdgcn_global_load_lds((const GAS unsigned*)(bbase + (size_t)(2 * bcs) * ldb + sw8 + (k0_)), lb_ + 8192 + 4096, 16, 0, 0); \
      if (NBC == 4) __builtin_amdgcn_global_load_lds((const GAS unsigned*)(bbase + (size_t)(3 * bcs) * ldb + sw8 + (k0_)), lb_ + 8192 + 6144, 16, 0, 0); } while (0)
#define G_BARV() asm volatile("s_waitcnt vmcnt(0) lgkmcnt(0)\n\ts_barrier" ::: "memory")
    if (!PRE) { G_DMA(0, 0); G_BARV(); }
#pragma unroll 1
    for (int kt = 0; kt < nk; ++kt) {
      if (NEXT && kt == nk - 1) {
        gcu16p An = (gcu16p)nx.A; gcu16p Bn = (gcu16p)nx.B + (size_t)(nx.n0 + lr) * nx.ldb + lch * 8 + sw8;
        ldsu lb_ = lbase;
#define G_NROW(i_) ({ int r_ = nx.m0 + lr + 64 * (i_); r_ = r_ < 0 ? 0 : (r_ > mmax ? mmax : r_); (size_t)r_ * nx.lda + lch * 8 + sw8; })
        __builtin_amdgcn_global_load_lds((const GAS unsigned*)(An + G_NROW(0)), lb_, 16, 0, 0);
        __builtin_amdgcn_global_load_lds((const GAS unsigned*)(An + G_NROW(1)), lb_ + 2048, 16, 0, 0);
        __builtin_amdgcn_global_load_lds((const GAS unsigned*)(An + G_NROW(2)), lb_ + 4096, 16, 0, 0);
        __builtin_amdgcn_global_load_lds((const GAS unsigned*)(An + G_NROW(3)), lb_ + 6144, 16, 0, 0);
        __builtin_amdgcn_global_load_lds((const GAS unsigned*)(Bn), lb_ + 8192, 16, 0, 0);
        if (nx.nbc >= 2) __builtin_amdgcn_global_load_lds((const GAS unsigned*)(Bn + (size_t)nx.bcs * nx.ldb), lb_ + 8192 + 2048, 16, 0, 0);
        if (nx.nbc >= 3) __builtin_amdgcn_global_load_lds((const GAS unsigned*)(Bn + (size_t)(2 * nx.bcs) * nx.ldb), lb_ + 8192 + 4096, 16, 0, 0);
        if (nx.nbc >= 4) __builtin_amdgcn_global_load_lds((const GAS unsigned*)(Bn + (size_t)(3 * nx.bcs) * nx.ldb), lb_ + 8192 + 6144, 16, 0, 0);
      } else {
        int k1 = (kt + 1) << 6; k1 = k1 > klast ? klast : k1; G_DMA((kt + 1) & 1, k1);
      }
      G_COMPUTE(smem + (kt & 1) * 65536);
      G_BARV();
    }
    if (!NEXT) __syncthreads();
    return;
  }
#endif
  G_LOAD(0);
  G_STORE(smem);
  G_LOAD(64);
  __syncthreads();
#pragma unroll 1
  for (int kt = 0; kt < nk; ++kt) {
    const char* sb = smem + (kt & 1) * 65536;
    char* sw = smem + ((kt + 1) & 1) * 65536;
    G_COMPUTE(sb);
    G_STORE(sw);
    G_BAR();
    { int k2 = (kt + 2) << 6; k2 = k2 > klast ? klast : k2; G_LOAD(k2); }
  }
  __syncthreads();
}

DI int xcd_tile(int k, int bid, int nb) { const int per = nb >> 3; return (k * 8 + (bid & 7)) * per + (bid >> 3); }
DI void tile_mn(int L, int MT, int NT, int& mt, int& nt) {
  const int g = L / (8 * NT), w = L - g * 8 * NT; const int gsz = (MT - g * 8) < 8 ? (MT - g * 8) : 8;
  nt = w / gsz; mt = g * 8 + (w - nt * gsz);
}

template <int MI, int NJ = 4>
DI void zero_acc(f32x4 (&acc)[MI][NJ]) {
#pragma unroll
  for (int i = 0; i < MI; ++i)
#pragma unroll
    for (int j = 0; j < NJ; ++j) acc[i][j] = zero4();
}

DI void conv_tile(const float* __restrict__ src, int ldn, int c0, int k0, u16* __restrict__ dst, int ldk, int r0, char* smem) {
  float* t = reinterpret_cast<float*>(smem);
  const int tid = tidx();
#pragma unroll
  for (int it = 0; it < 16; ++it) { int idx = tid + 256 * it; int kk = idx >> 6, cc = idx & 63; t[kk * 65 + cc] = src[(size_t)(k0 + kk) * ldn + c0 + cc]; }
  __syncthreads();
#pragma unroll
  for (int it = 0; it < 2; ++it) {
    int ch = tid + 256 * it; int n = ch >> 3, kc = ch & 7;
    uint4 v;
    v.x = pack2(t[(kc * 8 + 0) * 65 + n], t[(kc * 8 + 1) * 65 + n]);
    v.y = pack2(t[(kc * 8 + 2) * 65 + n], t[(kc * 8 + 3) * 65 + n]);
    v.z = pack2(t[(kc * 8 + 4) * 65 + n], t[(kc * 8 + 5) * 65 + n]);
    v.w = pack2(t[(kc * 8 + 6) * 65 + n], t[(kc * 8 + 7) * 65 + n]);
    *reinterpret_cast<uint4*>(dst + (size_t)(r0 + n) * ldk + k0 + kc * 8) = v;
  }
  __syncthreads();
}

#define N_CONV_ITEMS 4800
DI void conv_item(const Params& p, int l, int it, char* smem) {
  if (it < 1920) { int nb = it >> 4, kb = it & 15; conv_tile(p.w_in + (size_t)l * 1024 * 7680, 7680, nb * 64, kb * 64, p.WinT, 1024, nb * 64, smem); return; }
  it -= 1920;
  if (it < 384) { int i = it >> 7, r = it & 127; int nb = r >> 3, kb = r & 7;
    conv_tile(p.w_branch + (size_t)(l * 3 + i) * 512 * 1024, 1024, nb * 64, kb * 64, p.WbT + (size_t)i * 1024 * 512, 512, nb * 64, smem); return; }
  it -= 384;
  if (it < 256) { int nb = it >> 4, kb = it & 15; conv_tile(p.w_out + (size_t)l * 1024 * 1024, 1024, nb * 64, kb * 64, p.WoT, 1024, nb * 64, smem); return; }
  it -= 256;
  if (it < 1408) { int nb = it >> 4, kb = it & 15; const int tl = nb >> 2, w = nb & 3; int c0 = w < 2 ? tl * 128 + w * 64 : 2816 + tl * 128 + (w - 2) * 64;
    conv_tile(p.ffn_w_up + (size_t)l * 1024 * 5632, 5632, c0, kb * 64, p.WupT, 1024, nb * 64, smem); return; }
  it -= 1408;
  if (it < 704) { int nb = it / 44, kb = it % 44; conv_tile(p.ffn_w_down + (size_t)l * 2816 * 1024, 1024, nb * 64, kb * 64, p.WdT, 2816, nb * 64, smem); return; }
  it -= 704;
  for (int e = tidx(); e < 2048; e += 256) {
    int idx = it * 2048 + e; int row = idx >> 10, k = idx & 1023;
    float v = row < 32 ? p.gla_wa1[(((size_t)l * 2 + (row >> 4)) * 1024 + k) * 16 + (row & 15)] : 0.f;
    p.WinT[(size_t)(7680 + row) * 1024 + k] = f2bf(v);
  }
}

DI void ada_item(const Params& p, int it, char* smem) {
  const int l = it / 96, cb = it % 96, tid = tidx();
  float* ssil = reinterpret_cast<float*>(smem);
  float* red = ssil + 3072;
  for (int i = tid; i < 3072; i += 256) { int j = i >> 10, k = i & 1023; float v = j == 0 ? p.c_ctx[k] : p.c[(j - 1) * 1024 + k]; ssil[i] = siluf_(v); }
  __syncthreads();
  const int c = tid & 63, kg = tid >> 6;
  const float* w = p.ada_w + (size_t)l * 1024 * 6144 + cb * 64 + c;
  float a0 = 0.f, a1 = 0.f, a2 = 0.f;
#pragma unroll 32
  for (int k = kg * 256; k < kg * 256 + 256; ++k) { float wv = w[(size_t)k * 6144]; a0 += ssil[k] * wv; a1 += ssil[1024 + k] * wv; a2 += ssil[2048 + k] * wv; }
  red[(kg * 3 + 0) * 64 + c] = a0; red[(kg * 3 + 1) * 64 + c] = a1; red[(kg * 3 + 2) * 64 + c] = a2;
  __syncthreads();
  if (tid < 192) { int j = tid >> 6; float s = p.ada_b[l * 6144 + cb * 64 + c];
    for (int g = 0; g < 4; ++g) s += red[(g * 3 + j) * 64 + c];
    p.mod[(l * 3 + j) * 6144 + cb * 64 + c] = s; }
  __syncthreads();
}

DI void misc_item(const Params& p) {
  const int tid = tidx();
  if (tid < 16) {
    int a = tid >> 2, b = tid & 3;
    double th = (b == 0 ? 1.0 : b == 1 ? 0.5623413251903491 : b == 2 ? 0.31622776601683794 : 0.1778279410038923);
    th *= (a == 0 ? 1.0 : a == 1 ? 0.1 : a == 2 ? 0.01 : 0.001);
    double t2 = th * th, cs = 1.0, sn = th, tc = 1.0, ts = th;
    for (int n = 1; n < 14; ++n) { tc *= -t2 / ((2.0 * n - 1.0) * (2.0 * n)); cs += tc; ts *= -t2 / ((2.0 * n) * (2.0 * n + 1.0)); sn += ts; }
    double c = 1.0, s = 0.0;
    for (int pos = 0; pos < 64; ++pos) { p.rope[(pos * 16 + tid) * 2] = (float)c; p.rope[(pos * 16 + tid) * 2 + 1] = (float)s; double cn = c * cs - s * sn; s = s * cs + c * sn; c = cn; }
  } else if (tid == 32 || tid == 33) {
    int l = tid - 32; const float* lp = p.diff_lam + l * 256; float s1 = 0.f, s2 = 0.f;
    for (int d = 0; d < 64; ++d) { s1 += lp[d] * lp[64 + d]; s2 += lp[128 + d] * lp[192 + d]; }
    float li = 0.8f - 0.6f * expf(-0.3f * (float)l);
    p.lam[l * 2] = expf(s1) - expf(s2) + li; p.lam[l * 2 + 1] = li;
  }
}

DI void phase_pr0(const Params& p, char* smem, int bid, int nb) {
  if (bid == 0) misc_item(p);
  const int total = N_CONV_ITEMS + 192;
  for (int it = bid; it < total; it += nb) {
    if (it < 192) ada_item(p, it, smem);
    else conv_item(p, 0, it - 192, smem);
  }
}

DI void phase_pr1(const Params& p, int bid, int nb) {
  const int lane = tidx() & 63, wid = tidx() >> 6;
  for (int row = bid * 4 + wid; row < NTOK; row += nb * 4) {
    const float* xr = row < 4096 ? p.x_prompt + (size_t)row * 1024 : p.x_sample + (size_t)(row - 4096) * 1024;
    const float* md = p.mod + (0 * 3 + tok_cv(row)) * 6144;
    f32x4 vin[4], shv[4], scv[4];
#pragma unroll
    for (int it = 0; it < 4; ++it) { vin[it] = *(const GAS f32x4*)(xr + it * 256 + lane * 4);
      shv[it] = *(const GAS f32x4*)(md + it * 256 + lane * 4); scv[it] = *(const GAS f32x4*)(md + 1024 + it * 256 + lane * 4); }
#pragma unroll
    for (int it = 0; it < 4; ++it) {
      int col = it * 256 + lane * 4;
      float4 v; v.x = vin[it][0]; v.y = vin[it][1]; v.z = vin[it][2]; v.w = vin[it][3];
      float4 sh, sc; sh.x = shv[it][0]; sh.y = shv[it][1]; sh.z = shv[it][2]; sh.w = shv[it][3]; sc.x = scv[it][0]; sc.y = scv[it][1]; sc.z = scv[it][2]; sc.w = scv[it][3];
      uint2 o; o.x = pack2(v.x * (1.f + sc.x) + sh.x, v.y * (1.f + sc.y) + sh.y); o.y = pack2(v.z * (1.f + sc.z) + sh.z, v.w * (1.f + sc.w) + sh.w);
      *reinterpret_cast<uint2*>(p.h + (size_t)row * 1024 + col) = o;
    }
  }
}

DI void rot(float& a, float& b, float c, float s) { float na = a * c - b * s; b = b * c + a * s; a = na; }

DI void epi_p1(const Params& p, int l, f32x4 (&acc)[8][4], int m0, int nt) {
  const int lane = rtid() & 63, wid = rtid() >> 6, wm = wid >> 2, wn = wid & 3;
  const int lq = lane >> 4, lc = lane & 15;
  const int rbase = m0 + wm * 128;
  if (nt == 18) {
    if (wn == 0) {
#pragma unroll
      for (int mi = 0; mi < 8; ++mi)
#pragma unroll
        for (int j = 0; j < 4; ++j) { int tok = rbase + mi * 16 + lq * 4 + j; p.r[tok * 32 + lc] = acc[mi][0][j]; p.r[tok * 32 + 16 + lc] = acc[mi][1][j]; }
    }
    return;
  }
  const int cb = nt * 256 + wn * 64;
  if (cb >= 4096) {
    const int head = (cb - 4096) >> 7, dvb = (cb - 4096) & 127;
#pragma unroll
    for (int mi = 0; mi < 8; ++mi) {
      const int tok0 = rbase + mi * 16 + lq * 4;
#pragma unroll
      for (int ni = 0; ni < 4; ++ni) {
        const int dv = dvb + ni * 16 + lc;
        uint2 o; o.x = pack2(acc[mi][ni][0], acc[mi][ni][1]); o.y = pack2(acc[mi][ni][2], acc[mi][ni][3]);
        if (tok0 < 4096) {
          int b = tok0 >> 8, t = tok0 & 255;
          *reinterpret_cast<uint2*>(p.VcT_p + ((size_t)(b * 4 + head) * 128 + dv) * 256 + t) = o;
          float* ov = p.out + OUT_DV + ((size_t)((b * 2 + l) * 4 + head) * 256 + t) * 128 + dv;
#pragma unroll
          for (int j = 0; j < 4; ++j) ov[j * 128] = acc[mi][ni][j];
        } else {
          int bs = (tok0 - 4096) >> 12, t = (tok0 - 4096) & 4095;
          *reinterpret_cast<uint2*>(p.VcT_s + ((size_t)(bs * 4 + head) * 128 + dv) * 4352 + 256 + t) = o;
        }
      }
    }
    return;
  }
  const bool rope = (cb < 512) || (cb >= 3072);
  const float scale = ((cb >= 256 && cb < 512) || (cb >= 1536 && cb < 1792)) ? 0.125f : (cb >= 3072 && cb < 3584) ? 0.125f * LOG2E_F : 1.f;
  const bool dorope = rope && (m0 >= 4096);
#pragma unroll
  for (int mi = 0; mi < 8; ++mi) {
    float2 ra = make_float2(1.f, 0.f), rb4[4];
#pragma unroll
    for (int j = 0; j < 4; ++j) rb4[j] = make_float2(1.f, 0.f);
    if (dorope) {
      const int t0 = (rbase + mi * 16 + lq * 4 - 4096) & 4095;
      ra = *reinterpret_cast<const float2*>(p.rope + ((t0 >> 6) * 16 + lc) * 2);
#pragma unroll
      for (int j = 0; j < 4; ++j) rb4[j] = *reinterpret_cast<const float2*>(p.rope + (((t0 & 63) + j) * 16 + lc) * 2);
    }
#pragma unroll
    for (int j = 0; j < 4; ++j) {
      const int tok = rbase + mi * 16 + lq * 4 + j;
      float v0 = acc[mi][0][j] * scale, v1 = acc[mi][1][j] * scale, v2 = acc[mi][2][j] * scale, v3 = acc[mi][3][j] * scale;
      if (dorope) { rot(v0, v1, ra.x, ra.y); rot(v2, v3, rb4[j].x, rb4[j].y); }
      if (cb < 3584) {
        u16* d = p.proj + (size_t)tok * PLD + cb + lc;
        d[0] = f2bf(v0); d[16] = f2bf(v1); d[32] = f2bf(v2); d[48] = f2bf(v3);
      } else {
        const int g = (cb - 3584) >> 6;
        if (tok < 4096) {
          int b = tok >> 8, t = tok & 255;
          u16* d = p.Kc_p + ((size_t)(b * 8 + g) * 256 + t) * 64 + lc;
          d[0] = f2bf(v0); d[16] = f2bf(v1); d[32] = f2bf(v2); d[48] = f2bf(v3);
          float* o = p.out + OUT_DK + ((size_t)((b * 2 + l) * 8 + g) * 256 + t) * 64 + lc;
          o[0] = v0; o[16] = v1; o[32] = v2; o[48] = v3;
        } else {
          int bs = (tok - 4096) >> 12, t = (tok - 4096) & 4095;
          u16* d = p.Kc_s + ((size_t)(bs * 8 + g) * 4352 + 256 + t) * 64 + lc;
          d[0] = f2bf(v0); d[16] = f2bf(v1); d[32] = f2bf(v2); d[48] = f2bf(v3);
        }
      }
    }
  }
}

DI void ctx_item(const Params& p, int l, int it) {
  const int tid = tidx();
  if (it < 64) {
#pragma unroll
    for (int e0 = 0; e0 < 4096; e0 += 2048) {
      float v[8];
#pragma unroll
      for (int k = 0; k < 8; ++k) { const int idx = it * 4096 + e0 + k * 256 + tid;
        const int d = idx & 63, pos = (idx >> 6) & 255, g = (idx >> 14) & 7, b = idx >> 17;
        v[k] = ((const GAS float*)p.cache_k)[((size_t)((b * 2 + l) * 8 + g) * 256 + pos) * 64 + d]; }
#pragma unroll
      for (int k = 0; k < 8; ++k) { const int idx = it * 4096 + e0 + k * 256 + tid;
        const int d = idx & 63, pos = (idx >> 6) & 255, g = (idx >> 14) & 7, b = idx >> 17;
        p.Kc_s[((size_t)(b * 8 + g) * 4352 + pos) * 64 + d] = f2bf(v[k]); }
    }
  } else {
    it -= 64;
#pragma unroll
    for (int e0 = 0; e0 < 4096; e0 += 2048) {
      float v[8];
#pragma unroll
      for (int k = 0; k < 8; ++k) { const int idx = it * 4096 + e0 + k * 256 + tid;
        const int dv = idx & 127, pos = (idx >> 7) & 255, hd = (idx >> 15) & 3, b = idx >> 17;
        v[k] = ((const GAS float*)p.cache_v)[((size_t)((b * 2 + l) * 4 + hd) * 256 + pos) * 128 + dv]; }
#pragma unroll
      for (int k = 0; k < 8; ++k) { const int idx = it * 4096 + e0 + k * 256 + tid;
        const int dv = idx & 127, pos = (idx >> 7) & 255, hd = (idx >> 15) & 3, b = idx >> 17;
        p.VcT_s[((size_t)(b * 4 + hd) * 128 + dv) * 4352 + pos] = f2bf(v[k]); }
    }
  }
}

DI void phase_p1(const Params& p, int l, char* smem, int bid, int nb, int vbid, int vnb) {
  for (int it = vbid; it < 128; it += vnb) ctx_item(p, l, it);
  const int ntiles = 48 * 19;
  bool pre = false;
  for (int k = 0;; ++k) {
    const int it = xcd_tile(k, bid, nb);
    if (k * nb >= ntiles) break;
    if (it >= ntiles) continue;
    int mt, nt; tile_mn(it, 48, 19, mt, nt);
    const int it2 = xcd_tile(k + 1, bid, nb);
    const bool has_next = ((k + 1) * nb < ntiles) && (it2 < ntiles);
    int mt2 = 0, nt2 = 0; if (has_next) tile_mn(it2, 48, 19, mt2, nt2);
    const GemmNext nx{p.h, 1024, p.WinT, 1024, nt2 < 18 ? nt2 * 256 : 7680, 64, 4, mt2 * 256};
    f32x4 acc[8][4]; zero_acc<8>(acc);
    if (pre) { if (has_next) gemm_main<8, false, 4, true, true>(acc, p.h, 1024, mt * 256, NTOK - 1, p.WinT, 1024, nt < 18 ? nt * 256 : 7680, 1024, smem, 64, nx);
               else gemm_main<8, false, 4, true, false>(acc, p.h, 1024, mt * 256, NTOK - 1, p.WinT, 1024, nt < 18 ? nt * 256 : 7680, 1024, smem); }
    else     { if (has_next) gemm_main<8, false, 4, false, true>(acc, p.h, 1024, mt * 256, NTOK - 1, p.WinT, 1024, nt < 18 ? nt * 256 : 7680, 1024, smem, 64, nx);
               else gemm_main<8, false, 4, false, false>(acc, p.h, 1024, mt * 256, NTOK - 1, p.WinT, 1024, nt < 18 ? nt * 256 : 7680, 1024, smem); }
    pre = has_next;
    epi_p1(p, l, acc, mt * 256, nt);
  }
}

struct ChunkItem { int mixer, seq, chunk, h, tok0, sample, bidx; };
DI ChunkItem chunk_item(int it) {
  ChunkItem c; c.mixer = it / 768; int i = it % 768;
  if (i < 512) { c.sample = 1; int s = i >> 6; c.seq = 64 + s; c.chunk = i & 63; c.bidx = s >> 2; c.h = s & 3; c.tok0 = 4096 + c.bidx * 4096 + c.chunk * 64; }
  else { int j = i - 512; c.sample = 0; int s = j >> 2; c.seq = s; c.chunk = j & 3; c.bidx = s >> 2; c.h = s & 3; c.tok0 = c.bidx * 256 + c.chunk * 64; }
  return c;
}
DI size_t scan_off(const ChunkItem& c, int dir) {
  return (size_t)c.mixer * SCAN_MIX_ELEMS + (c.sample ? SCAN_SAMPLE_OFF + ((size_t)((c.seq - 64) * 2 + dir) * 64 + c.chunk) * 8192
                                                       : ((size_t)(c.seq * 2 + dir) * 4 + c.chunk) * 8192);
}
DI int dec_off(const ChunkItem& c, int dir) {
  return c.mixer * DEC_MIX + (c.sample ? DEC_SAMPLE_OFF + (((c.seq - 64) * 2 + dir) * 64 + c.chunk) * 64 : ((c.seq * 2 + dir) * 4 + c.chunk) * 64);
}

DI void compute_cum(const Params& p, int l, const ChunkItem& c, int e, float* sCum, float* sTot, float* sR) {
  const int tid = tidx();
  if (c.mixer == 0) {
    const float lg = logsigf_(p.ret_decay[(l * 2 + e) * 4 + c.h]);
    for (int idx = tid; idx < 4096; idx += 256) { int i = idx >> 6; sCum[idx] = (e == 0 ? (float)(i + 1) : (float)(64 - i)) * lg; }
    __syncthreads();
    return;
  }
  const int dk = tid & 63, qq = tid >> 6;
  const float* wa2 = p.gla_wa2 + ((size_t)(l * 2 + e) * 16) * 256 + c.h * 64 + dk;
  float w[16];
#pragma unroll
  for (int r = 0; r < 16; ++r) w[r] = wa2[r * 256];
  const float ba = p.gla_ba[(l * 2 + e) * 256 + c.h * 64 + dk];
  *reinterpret_cast<f32x4*>(sR + tid * 4) = *(const GAS f32x4*)(p.r + (size_t)(c.tok0 + (tid >> 2)) * 32 + e * 16 + (tid & 3) * 4);
  __syncthreads();
  float run = 0.f;
#pragma unroll 4
  for (int s = 0; s < 16; ++s) {
    const int i = e == 0 ? qq * 16 + s : qq * 16 + 15 - s;
    const float4* rp = reinterpret_cast<const float4*>(sR + i * 16);
    float4 r0 = rp[0], r1 = rp[1], r2 = rp[2], r3 = rp[3];
    float z = ba + r0.x * w[0] + r0.y * w[1] + r0.z * w[2] + r0.w * w[3] + r1.x * w[4] + r1.y * w[5] + r1.z * w[6] + r1.w * w[7]
                 + r2.x * w[8] + r2.y * w[9] + r2.z * w[10] + r2.w * w[11] + r3.x * w[12] + r3.y * w[13] + r3.z * w[14] + r3.w * w[15];
    run += logsigf_(z) * 0.0625f;
    sCum[i * 64 + dk] = run;
  }
  sTot[qq * 64 + dk] = run;
  __syncthreads();
  float off = 0.f;
  for (int g = 0; g < 4; ++g) if (e == 0 ? g < qq : g > qq) off += sTot[g * 64 + dk];
#pragma unroll 4
  for (int s = 0; s < 16; ++s) sCum[(qq * 16 + s) * 64 + dk] += off;
  __syncthreads();
}

DI void load_vt(const Params& p, const ChunkItem& c, u16* sVT) {
  const int tid = tidx();
  const int vcol = (c.mixer == 0 ? 512 : 2048) + c.h * 128;
#pragma unroll
  for (int it = 0; it < 4; ++it) {
    int ch = tid + 256 * it; int i = ch & 63, dvc = ch >> 6;
    uint4 v = *reinterpret_cast<const uint4*>(p.proj + (size_t)(c.tok0 + i) * PLD + vcol + dvc * 8);
    const u16* e = reinterpret_cast<const u16*>(&v);
#pragma unroll
    for (int k = 0; k < 8; ++k) sVT[(dvc * 8 + k) * 72 + i] = e[k];
  }
}

DI void p2a_item(const Params& p, int l, int it, char* smem) {
  const ChunkItem c = chunk_item(it);
  float* sCum = reinterpret_cast<float*>(smem);
  float* sTot = reinterpret_cast<float*>(smem + 16384);
  u16* sVT = reinterpret_cast<u16*>(smem + 17408);
  u16* sKT = reinterpret_cast<u16*>(smem + 35840);
  const int tid = tidx(), lane = tid & 63, wid = tid >> 6, lr16 = lane & 15, q = lane >> 4;
  const int kcol = (c.mixer == 0 ? 256 : 1792) + c.h * 64;
  u32x4 kreg0, kreg1;
  {
    gcu16p pg = (gcu16p)p.proj;
    kreg0 = *(gcu4p)(pg + (size_t)(c.tok0 + (tid & 63)) * PLD + kcol + (tid >> 6) * 8);
    kreg1 = *(gcu4p)(pg + (size_t)(c.tok0 + (tid & 63)) * PLD + kcol + ((tid >> 6) + 4) * 8);
  }
  load_vt(p, c, sVT);
  for (int e = 0; e < 2; ++e) {
    compute_cum(p, l, c, e, sCum, sTot, reinterpret_cast<float*>(smem + 45056));
    const int iref = e == 0 ? 63 : 0;
#define P2A_KT(kr_, dkc_) do { const int i = tid & 63; \
      _Pragma("unroll") for (int k = 0; k < 4; ++k) { \
        const int dk = (dkc_) * 8 + 2 * k; \
        sKT[dk * 72 + i] = f2bf(__uint_as_float(kr_[k] << 16) * __expf(sCum[iref * 64 + dk] - sCum[i * 64 + dk])); \
        sKT[(dk + 1) * 72 + i] = f2bf(__uint_as_float(kr_[k] & 0xffff0000u) * __expf(sCum[iref * 64 + dk + 1] - sCum[i * 64 + dk + 1])); } } while (0)
    P2A_KT(kreg0, (tid >> 6)); P2A_KT(kreg1, (tid >> 6) + 4);
    if (tid < 64) p.dec[dec_off(c, e) + tid] = __expf(sCum[iref * 64 + tid]);
    __syncthreads();
    f32x4 acc[2][4];
#pragma unroll
    for (int mi = 0; mi < 2; ++mi)
#pragma unroll
      for (int ni = 0; ni < 4; ++ni) acc[mi][ni] = zero4();
#pragma unroll
    for (int ks = 0; ks < 2; ++ks) {
      bf16x8 af[2], bfr[4];
#pragma unroll
      for (int mi = 0; mi < 2; ++mi) af[mi] = *reinterpret_cast<const bf16x8*>(sVT + (wid * 32 + mi * 16 + lr16) * 72 + ks * 32 + q * 8);
#pragma unroll
      for (int ni = 0; ni < 4; ++ni) bfr[ni] = *reinterpret_cast<const bf16x8*>(sKT + (ni * 16 + lr16) * 72 + ks * 32 + q * 8);
#pragma unroll
      for (int mi = 0; mi < 2; ++mi)
#pragma unroll
        for (int ni = 0; ni < 4; ++ni) acc[mi][ni] = MFMA16(af[mi], bfr[ni], acc[mi][ni]);
    }
    u16* dst = p.scan + scan_off(c, e);
#pragma unroll
    for (int mi = 0; mi < 2; ++mi)
#pragma unroll
      for (int ni = 0; ni < 4; ++ni)
#pragma unroll
        for (int j = 0; j < 4; ++j) dst[(wid * 32 + mi * 16 + q * 4 + j) * 64 + ni * 16 + lr16] = f2bf(acc[mi][ni][j]);
    __syncthreads();
  }
}

template <int NCH>
DI void scan_unit(const Params& p, int l, int mixer, int seq, int dir, int eb, int sample) {
  const int el = eb * 256 + tidx(); const int dv = el >> 6, dk = el & 63;
  const int bidx = sample ? (seq - 64) >> 2 : seq >> 2; const int h = seq & 3;
  u16* buf = p.scan + (size_t)mixer * SCAN_MIX_ELEMS + (sample ? SCAN_SAMPLE_OFF + (size_t)((seq - 64) * 2 + dir) * 64 * 8192 : (size_t)(seq * 2 + dir) * 4 * 8192) + el;
  const float* dc = p.dec + mixer * DEC_MIX + (sample ? DEC_SAMPLE_OFF + ((seq - 64) * 2 + dir) * 64 * 64 : (seq * 2 + dir) * 4 * 64) + dk;
  float s = 0.f;
  if (sample) { const float* st = mixer == 0 ? p.state_ret : p.state_gla; s = st[((size_t)((bidx * 2 + l) * 2 + dir) * 4 + h) * 8192 + dk * 128 + dv]; }
  constexpr int BT = NCH < 16 ? NCH : 16;
  for (int n0 = 0; n0 < NCH; n0 += BT) {
    float d[BT], g[BT];
#pragma unroll
    for (int k = 0; k < BT; ++k) { int n = dir == 0 ? n0 + k : NCH - 1 - n0 - k; d[k] = bf2f(buf[(size_t)n * 8192]); g[k] = dc[n * 64]; }
#pragma unroll
    for (int k = 0; k < BT; ++k) { int n = dir == 0 ? n0 + k : NCH - 1 - n0 - k; buf[(size_t)n * 8192] = f2bf(s); s = g[k] * s + d[k]; }
  }
  if (!sample) { float* o = p.out + (mixer == 0 ? OUT_SRET : OUT_SGLA); o[((size_t)((bidx * 2 + l) * 2 + dir) * 4 + h) * 8192 + dk * 128 + dv] = s; }
}
DI void scan_quad(const Params& p, int l, int mixer, int seq, int dir, int eb0) {
  const int tid = tidx(); const int dk = tid & 63;
  const int bidx = seq >> 2, h = seq & 3;
  u16* buf = p.scan + (size_t)mixer * SCAN_MIX_ELEMS + (size_t)(seq * 2 + dir) * 4 * 8192 + eb0 * 256 + tid;
  const float* dc = p.dec + mixer * DEC_MIX + (seq * 2 + dir) * 4 * 64 + dk;
  float d[4][4], g[4];
#pragma unroll
  for (int k = 0; k < 4; ++k) { const int n = dir == 0 ? k : 3 - k; g[k] = dc[n * 64];
#pragma unroll
    for (int q = 0; q < 4; ++q) d[q][k] = bf2f(buf[(size_t)n * 8192 + q * 256]); }
  float s[4] = {0.f, 0.f, 0.f, 0.f};
#pragma unroll
  for (int k = 0; k < 4; ++k) { const int n = dir == 0 ? k : 3 - k;
#pragma unroll
    for (int q = 0; q < 4; ++q) { buf[(size_t)n * 8192 + q * 256] = f2bf(s[q]); s[q] = g[k] * s[q] + d[q][k]; } }
  float* o = p.out + (mixer == 0 ? OUT_SRET : OUT_SGLA) + ((size_t)((bidx * 2 + l) * 2 + dir) * 4 + h) * 8192;
#pragma unroll
  for (int q = 0; q < 4; ++q) { const int el = (eb0 + q) * 256 + tid; o[(el & 63) * 128 + (el >> 6)] = s[q]; }
}
DI void phase_p2b(const Params& p, int l, int bid, int nb) {
  for (int u = bid; u < 1024 + 2048; u += nb) {
    if (u < 1024) { int mixer = u >> 9, rem = u & 511; scan_unit<64>(p, l, mixer, 64 + (rem >> 6), (rem >> 5) & 1, rem & 31, 1); }
    else { int v = u - 1024; int mixer = v >> 10, rem = v & 1023; scan_quad(p, l, mixer, rem >> 4, (rem >> 3) & 1, (rem & 7) * 4); }
  }
}

DI void p2c_mix_item(const Params& p, int l, int it, char* smem) {
  const ChunkItem c = chunk_item(it);
  u16* sQf = reinterpret_cast<u16*>(smem);
  u16* sQb = reinterpret_cast<u16*>(smem + 9216);
  u16* sKf = reinterpret_cast<u16*>(smem + 18432);
  u16* sKb = reinterpret_cast<u16*>(smem + 27648);
  float* sCum = reinterpret_cast<float*>(smem + 36864);
  u16* sVT = reinterpret_cast<u16*>(smem + 36864);
  u16* sP = reinterpret_cast<u16*>(smem + 55296);
  float* sTot = reinterpret_cast<float*>(smem + 64512);
  const int tid = tidx(), lane = tid & 63, wid = tid >> 6, lr16 = lane & 15, q = lane >> 4;
  const int qcol = (c.mixer == 0 ? 0 : 1536) + c.h * 64, kcol = (c.mixer == 0 ? 256 : 1792) + c.h * 64;
  u32x4 qv0, qv1, kv0, kv1, vv0, vv1, vv2, vv3;
  {
    gcu16p pg = (gcu16p)p.proj;
    const int i0 = tid >> 3, dkc = tid & 7;
    qv0 = *(gcu4p)(pg + (size_t)(c.tok0 + i0) * PLD + dkc * 8 + qcol); qv1 = *(gcu4p)(pg + (size_t)(c.tok0 + i0 + 32) * PLD + dkc * 8 + qcol);
    kv0 = *(gcu4p)(pg + (size_t)(c.tok0 + i0) * PLD + dkc * 8 + kcol); kv1 = *(gcu4p)(pg + (size_t)(c.tok0 + i0 + 32) * PLD + dkc * 8 + kcol);
    const int vcol = (c.mixer == 0 ? 512 : 2048) + c.h * 128; const int vi = tid & 63, dvc = tid >> 6;
    vv0 = *(gcu4p)(pg + (size_t)(c.tok0 + vi) * PLD + vcol + dvc * 8); vv1 = *(gcu4p)(pg + (size_t)(c.tok0 + vi) * PLD + vcol + (dvc + 4) * 8);
    vv2 = *(gcu4p)(pg + (size_t)(c.tok0 + vi) * PLD + vcol + (dvc + 8) * 8); vv3 = *(gcu4p)(pg + (size_t)(c.tok0 + vi) * PLD + vcol + (dvc + 12) * 8);
  }
  bf16x8 stf[2][8], stb[2][8];
  {
    typedef const GAS bf16x8* gfrag;
    gcu16p STf = (gcu16p)p.scan + scan_off(c, 0);
    gcu16p STb = (gcu16p)p.scan + scan_off(c, 1);
    const int lr16_ = (tid & 63) & 15, q_ = (tid & 63) >> 4;
#pragma unroll
    for (int ks = 0; ks < 2; ++ks)
#pragma unroll
      for (int nd = 0; nd < 8; ++nd) {
        stf[ks][nd] = *(gfrag)(STf + (nd * 16 + lr16_) * 64 + ks * 32 + q_ * 8);
        stb[ks][nd] = *(gfrag)(STb + (nd * 16 + lr16_) * 64 + ks * 32 + q_ * 8);
      }
  }
#define MIX_BUILD(qv_, kv_, i_) do { const int dkc = tid & 7; \
      float cm[8]; _Pragma("unroll") for (int k = 0; k < 8; ++k) cm[k] = sCum[(i_) * 64 + dkc * 8 + k]; \
      u32x4 qo, ko; \
      _Pragma("unroll") for (int k = 0; k < 4; ++k) { \
        const float q0 = __uint_as_float(qv_[k] << 16), q1 = __uint_as_float(qv_[k] & 0xffff0000u); \
        const float k0 = __uint_as_float(kv_[k] << 16), k1 = __uint_as_float(kv_[k] & 0xffff0000u); \
        qo[k] = pack2(q0 * __expf(cm[2 * k]), q1 * __expf(cm[2 * k + 1])); \
        ko[k] = pack2(k0 * __expf(-cm[2 * k]), k1 * __expf(-cm[2 * k + 1])); } \
      *reinterpret_cast<u32x4*>(sQ + (i_) * 72 + dkc * 8) = qo; \
      *reinterpret_cast<u32x4*>(sK + (i_) * 72 + dkc * 8) = ko; } while (0)
  for (int e = 0; e < 2; ++e) {
    compute_cum(p, l, c, e, sCum, sTot, reinterpret_cast<float*>(smem + 55296));
    u16* sQ = e == 0 ? sQf : sQb; u16* sK = e == 0 ? sKf : sKb;
    MIX_BUILD(qv0, kv0, (tid >> 3));
    MIX_BUILD(qv1, kv1, (tid >> 3) + 32);
    __syncthreads();
  }
#define MIX_VT(vv_, dvc_) do { const int vi = tid & 63; \
      _Pragma("unroll") for (int k = 0; k < 4; ++k) { sVT[((dvc_) * 8 + 2 * k) * 72 + vi] = (u16)(vv_[k] & 0xffffu); sVT[((dvc_) * 8 + 2 * k + 1) * 72 + vi] = (u16)(vv_[k] >> 16); } } while (0)
  MIX_VT(vv0, (tid >> 6)); MIX_VT(vv1, (tid >> 6) + 4); MIX_VT(vv2, (tid >> 6) + 8); MIX_VT(vv3, (tid >> 6) + 12);
  const int irow = wid * 16;
  bf16x8 aQf[2], aQb[2];
#pragma unroll
  for (int ks = 0; ks < 2; ++ks) { aQf[ks] = *reinterpret_cast<const bf16x8*>(sQf + (irow + lr16) * 72 + ks * 32 + q * 8); aQb[ks] = *reinterpret_cast<const bf16x8*>(sQb + (irow + lr16) * 72 + ks * 32 + q * 8); }
#pragma unroll
  for (int nj = 0; nj < 4; ++nj) {
    f32x4 sf = zero4(), sb = zero4();
#pragma unroll
    for (int ks = 0; ks < 2; ++ks) {
      bf16x8 kf = *reinterpret_cast<const bf16x8*>(sKf + (nj * 16 + lr16) * 72 + ks * 32 + q * 8);
      bf16x8 kb = *reinterpret_cast<const bf16x8*>(sKb + (nj * 16 + lr16) * 72 + ks * 32 + q * 8);
      sf = MFMA16(aQf[ks], kf, sf); sb = MFMA16(aQb[ks], kb, sb);
    }
    const int jj = nj * 16 + lr16;
#pragma unroll
    for (int j = 0; j < 4; ++j) { int i = irow + q * 4 + j; float v = jj < i ? sf[j] : (jj > i ? sb[j] : sf[j] + sb[j]); sP[i * 72 + jj] = f2bf(v); }
  }
  __syncthreads();
  f32x4 o[8];
#pragma unroll
  for (int nd = 0; nd < 8; ++nd) o[nd] = zero4();
#pragma unroll
  for (int ks = 0; ks < 2; ++ks) {
    bf16x8 aP = *reinterpret_cast<const bf16x8*>(sP + (irow + lr16) * 72 + ks * 32 + q * 8);
#pragma unroll
    for (int nd = 0; nd < 8; ++nd) {
      bf16x8 vb = *reinterpret_cast<const bf16x8*>(sVT + (nd * 16 + lr16) * 72 + ks * 32 + q * 8);
      o[nd] = MFMA16(aP, vb, o[nd]);
      o[nd] = MFMA16(aQf[ks], stf[ks][nd], o[nd]);
      o[nd] = MFMA16(aQb[ks], stb[ks][nd], o[nd]);
    }
  }
  const int gcol = (c.mixer == 0 ? 1024 : 2560) + c.h * 128, ycol = (c.mixer == 0 ? 512 : 2048) + c.h * 128;
  float gng[8];
#pragma unroll
  for (int nd = 0; nd < 8; ++nd) gng[nd] = c.mixer == 1 ? p.gla_norm_g[l * 128 + nd * 16 + lr16] : 1.f;
#pragma unroll
  for (int j = 0; j < 4; ++j) {
    float s = 0.f, ss = 0.f;
#pragma unroll
    for (int nd = 0; nd < 8; ++nd) { float v = o[nd][j]; s += v; ss += v * v; }
#pragma unroll
    for (int m = 1; m < 16; m <<= 1) { s += __shfl_xor(s, m); ss += __shfl_xor(ss, m); }
    const int tok = c.tok0 + irow + q * 4 + j;
    float mean, rstd;
    if (c.mixer == 0) { mean = s * (1.f / 128.f); float var = ss * (1.f / 128.f) - mean * mean; rstd = rsqrtf(fmaxf(var, 0.f) + EPS_F); }
    else { mean = 0.f; rstd = rsqrtf(ss * (1.f / 128.f) + EPS_F); }
    u16 gr[8];
#pragma unroll
    for (int nd = 0; nd < 8; ++nd) gr[nd] = ((const GAS u16*)p.proj)[(size_t)tok * PLD + gcol + nd * 16 + lr16];
#pragma unroll
    for (int nd = 0; nd < 8; ++nd) {
      const int dv = nd * 16 + lr16;
      float g = siluf_(bf2f(gr[nd]));
      float y = (o[nd][j] - mean) * rstd;
      if (c.mixer == 1) y *= gng[nd];
      p.proj[(size_t)tok * PLD + ycol + dv] = f2bf(y * g);
    }
  }
  __syncthreads();
}

DI void attn_item(const Params& p, int l, int it, char* smem) {
  int b, head, qb, Tk, tokbase;
  const u16 *Kc, *VcT;
  if (it < 256) { b = it >> 7; head = (it >> 5) & 3; qb = it & 31; Tk = 4352; tokbase = 4096 + b * 4096; Kc = p.Kc_s; VcT = p.VcT_s; }
  else { int j = it - 256; b = j >> 3; head = (j >> 1) & 3; qb = j & 1; Tk = 256; tokbase = b * 256; Kc = p.Kc_p; VcT = p.VcT_p; }
  const int tid = rtid(), lane = tid & 63, wid = tid >> 6, r = lane & 31, hh = lane >> 5;
  const int sub = wid >> 2, qrow0 = qb * 128 + 32 * (wid & 3);
  gcu16p K0 = (gcu16p)Kc + (size_t)(b * 8 + head * 2) * Tk * 64;
  gcu16p K1 = K0 + (size_t)Tk * 64;
  gcu16p VT = (gcu16p)VcT + (size_t)(b * 4 + head) * 128 * Tk;
  bf16x8 qf[4];
  {
    const u16* qp = p.proj + (size_t)(tokbase + qrow0 + r) * PLD + 3072 + (head * 2 + sub) * 64 + hh * 8;
#pragma unroll
    for (int ks = 0; ks < 4; ++ks) qf[ks] = *reinterpret_cast<const bf16x8*>(qp + ks * 16);
  }
  const int krow = tid >> 3, kch = tid & 7;
  const int ksw = (kch ^ ((krow >> 1) & 7)) << 4;
  u32x4 ak0, ak1, av0, av1, bk0, bk1, bv0, bv1;
#define ATT_GLOAD(P, t_) do { const int key0 = (t_) * 64; \
    P##k0 = *(gcu4p)(K0 + (size_t)(key0 + krow) * 64 + kch * 8); \
    P##k1 = *(gcu4p)(K1 + (size_t)(key0 + krow) * 64 + kch * 8); \
    P##v0 = *(gcu4p)(VT + (size_t)(krow) * Tk + key0 + kch * 8); \
    P##v1 = *(gcu4p)(VT + (size_t)(krow + 64) * Tk + key0 + kch * 8); } while (0)
#define ATT_VST(rv_, row_) do { const int f = ((row_) >> 1) & 15; \
      char* rowp = sbw + 16384 + (row_) * 128; \
      uint2 lo, hi; lo.x = rv_.x; lo.y = rv_.y; hi.x = rv_.z; hi.y = rv_.w; \
      *reinterpret_cast<uint2*>(rowp + (((2 * kch) ^ f) << 3)) = lo; \
      *reinterpret_cast<uint2*>(rowp + (((2 * kch + 1) ^ f) << 3)) = hi; } while (0)
#define ATT_SSTORE(P, sbw_) do { char* sbw = (sbw_); \
    *reinterpret_cast<u32x4*>(sbw + krow * 128 + ksw) = P##k0; \
    *reinterpret_cast<u32x4*>(sbw + 8192 + krow * 128 + ksw) = P##k1; \
    ATT_VST(P##v0, krow); ATT_VST(P##v1, krow + 64); } while (0)
  f32x16 oacc[4];
#pragma unroll
  for (int d = 0; d < 4; ++d)
#pragma unroll
    for (int i = 0; i < 16; ++i) oacc[d][i] = 0.f;
  float m_run = -1e30f, l_run = 0.f;
  const int nt = Tk >> 6;
  const int kswz = (r >> 1) & 7;
  const int vf = (r >> 1) & 15;
#define ATT_TILE(sb_) do { \
    const char* sK = (sb_) + sub * 8192; \
    const char* sV = (sb_) + 16384; \
    f32x16 st[2]; \
    _Pragma("unroll") for (int kb = 0; kb < 2; ++kb) { \
      _Pragma("unroll") for (int i = 0; i < 16; ++i) st[kb][i] = 0.f; \
      _Pragma("unroll") for (int ks = 0; ks < 4; ++ks) { \
        bf16x8 kf = *reinterpret_cast<const bf16x8*>(sK + (kb * 32 + r) * 128 + (((2 * ks + hh) ^ kswz) << 4)); \
        st[kb] = MFMA32(kf, qf[ks], st[kb]); } } \
    __builtin_amdgcn_sched_barrier(0); \
    float mx = st[0][0]; \
    _Pragma("unroll") for (int i = 1; i < 16; ++i) mx = fmaxf(mx, st[0][i]); \
    _Pragma("unroll") for (int i = 0; i < 16; ++i) mx = fmaxf(mx, st[1][i]); \
    mx = fmaxf(mx, __shfl_xor(mx, 32)); \
      \
    float alpha = 1.f; \
    if (!__all((mx - m_run) <= 8.f)) { \
      const float m_new = fmaxf(m_run, mx); \
      alpha = __builtin_amdgcn_exp2f(m_run - m_new); \
      m_run = m_new; \
      _Pragma("unroll") for (int d = 0; d < 4; ++d) \
        _Pragma("unroll") for (int i = 0; i < 16; ++i) oacc[d][i] *= alpha; \
    } \
    float ps = 0.f; \
    _Pragma("unroll") for (int kb = 0; kb < 2; ++kb) \
      _Pragma("unroll") for (int i = 0; i < 16; ++i) { float e = __builtin_amdgcn_exp2f(st[kb][i] - m_run); st[kb][i] = e; ps += e; } \
    l_run = l_run * alpha + ps; \
    __builtin_amdgcn_sched_barrier(0); \
    _Pragma("unroll") for (int kb = 0; kb < 2; ++kb) \
      _Pragma("unroll") for (int s2 = 0; s2 < 2; ++s2) { \
        union { bf16x8 v; unsigned u[4]; } pf; \
        pf.u[0] = pack2(st[kb][8 * s2 + 0], st[kb][8 * s2 + 1]); pf.u[1] = pack2(st[kb][8 * s2 + 2], st[kb][8 * s2 + 3]); \
        pf.u[2] = pack2(st[kb][8 * s2 + 4], st[kb][8 * s2 + 5]); pf.u[3] = pack2(st[kb][8 * s2 + 6], st[kb][8 * s2 + 7]); \
        const int u0 = 8 * kb + 4 * s2 + hh; \
        _Pragma("unroll") for (int d = 0; d < 4; ++d) { \
          const char* rowp = sV + (d * 32 + r) * 128; \
          union { bf16x8 v; uint2 h2[2]; } vfr; \
          vfr.h2[0] = *reinterpret_cast<const uint2*>(rowp + ((u0 ^ vf) << 3)); \
          vfr.h2[1] = *reinterpret_cast<const uint2*>(rowp + (((u0 + 2) ^ vf) << 3)); \
          oacc[d] = MFMA32(vfr.v, pf.v, oacc[d]); } \
        __builtin_amdgcn_sched_barrier(0); } } while (0)
#define ATT_BAR() asm volatile("s_waitcnt lgkmcnt(0)\n\ts_barrier" ::: "memory")
  ATT_GLOAD(a, 0);
  ATT_GLOAD(b, 1);
  ATT_SSTORE(a, smem);
  __syncthreads();
#pragma unroll 1
  for (int t = 0; t < nt; t += 2) {
    { int t2 = t + 2; t2 = t2 > nt - 1 ? nt - 1 : t2; ATT_GLOAD(a, t2); }
    ATT_TILE(smem);
    ATT_SSTORE(b, smem + 32768);
    ATT_BAR();
    { int t3 = t + 3; t3 = t3 > nt - 1 ? nt - 1 : t3; ATT_GLOAD(b, t3); }
    ATT_TILE(smem + 32768);
    ATT_SSTORE(a, smem);
    ATT_BAR();
  }
  __syncthreads();
  l_run += __shfl_xor(l_run, 32);
  const float inv = 1.f / l_run;
  float* sO = reinterpret_cast<float*>(smem);
  if (sub == 1) {
#pragma unroll
    for (int d = 0; d < 4; ++d)
#pragma unroll
      for (int i = 0; i < 16; ++i) { int dv = d * 32 + (i & 3) + 8 * (i >> 2) + 4 * hh; sO[((wid & 3) * 128 + dv) * 32 + r] = oacc[d][i] * inv; }
  }
  __syncthreads();
  if (sub == 0) {
    const float lam = p.lam[l * 2], li = p.lam[l * 2 + 1];
    float ss = 0.f;
#pragma unroll
    for (int d = 0; d < 4; ++d)
#pragma unroll
      for (int i = 0; i < 16; ++i) { int dv = d * 32 + (i & 3) + 8 * (i >> 2) + 4 * hh; float v = oacc[d][i] * inv - lam * sO[((wid & 3) * 128 + dv) * 32 + r]; oacc[d][i] = v; ss += v * v; }
    ss += __shfl_xor(ss, 32);
    const float sc = rsqrtf(ss * (1.f / 128.f) + EPS_F) * (1.f - li);
    u16* yp = p.proj + (size_t)(tokbase + qrow0 + r) * PLD + 3072 + head * 128;
    const float* gg = p.diff_subln_g + l * 128;
#pragma unroll
    for (int d = 0; d < 4; ++d)
#pragma unroll
      for (int g4 = 0; g4 < 4; ++g4) {
        const int dv = d * 32 + 8 * g4 + 4 * hh;
        uint2 o2; o2.x = pack2(oacc[d][4 * g4] * sc * gg[dv], oacc[d][4 * g4 + 1] * sc * gg[dv + 1]);
        o2.y = pack2(oacc[d][4 * g4 + 2] * sc * gg[dv + 2], oacc[d][4 * g4 + 3] * sc * gg[dv + 3]);
        *reinterpret_cast<uint2*>(yp + dv) = o2;
      }
  }
  __syncthreads();
}

DI void phase_p2a(const Params& p, int l, char* smem, int bid, int nb) { for (int it = bid; it < 1536; it += nb) p2a_item(p, l, it, smem); }
DI void phase_p2c(const Params& p, int l, char* smem_all, char* smem, int rbid, int rnb, int bid, int nb) {
  for (int it = rbid; it < 384; it += rnb) attn_item(p, l, it, smem_all);
  for (int it = bid; it < 1536; it += nb) p2c_mix_item(p, l, it, smem);
}

DI void phase_p3(const Params& p, int l, char* smem, int bid, int nb) {
  (void)l;
  u16* merged = p.scan;
  for (int k = 0;; ++k) {
    const int it = xcd_tile(k, bid, nb);
    if (k * nb >= 768) break;
    if (it >= 768) continue;
    int mt, nt; tile_mn(it, 48, 16, mt, nt);
    f32x4 sg[2][12]; zero_acc<2, 12>(sg);
    gemm_main<2, false, 12, false, true>(sg, p.h, 1024, mt * 256, NTOK - 1, p.WinT, 1024, 4608 + nt * 64, 1024, smem, 1024,
                                         GemmNext{p.proj + 512, PLD, p.WbT, 512, nt * 64, 64, 1, mt * 256});
    unsigned sgp[2][12][2];
#pragma unroll
    for (int a = 0; a < 2; ++a)
#pragma unroll
      for (int b = 0; b < 12; ++b) { sgp[a][b][0] = pack2(sigmoidf_(sg[a][b][0]), sigmoidf_(sg[a][b][1])); sgp[a][b][1] = pack2(sigmoidf_(sg[a][b][2]), sigmoidf_(sg[a][b][3])); __builtin_amdgcn_sched_barrier(0); }
    f32x4 tot[2][4]; zero_acc<2>(tot);
#pragma unroll
    for (int i = 0; i < 3; ++i) {
      f32x4 acc[2][4]; zero_acc<2>(acc);
      const int ycol = i == 0 ? 512 : (i == 1 ? 2048 : 3072);
      const int ycol2 = i == 0 ? 2048 : 3072;
      if (i < 2) gemm_main<2, false, 4, true, true>(acc, p.proj + ycol, PLD, mt * 256, NTOK - 1, p.WbT + (size_t)i * 1024 * 512, 512, nt * 64, 512, smem, 64,
                                                    GemmNext{p.proj + ycol2, PLD, p.WbT + (size_t)(i + 1) * 1024 * 512, 512, nt * 64, 64, 1, mt * 256});
      else gemm_main<2, false, 4, true, false>(acc, p.proj + ycol, PLD, mt * 256, NTOK - 1, p.WbT + (size_t)i * 1024 * 512, 512, nt * 64, 512, smem);
#pragma unroll
      for (int a = 0; a < 2; ++a)
#pragma unroll
        for (int b = 0; b < 4; ++b)
        {
          tot[a][b][0] += __uint_as_float(sgp[a][i * 4 + b][0] << 16) * acc[a][b][0];
          tot[a][b][1] += __uint_as_float(sgp[a][i * 4 + b][0] & 0xffff0000u) * acc[a][b][1];
          tot[a][b][2] += __uint_as_float(sgp[a][i * 4 + b][1] << 16) * acc[a][b][2];
          tot[a][b][3] += __uint_as_float(sgp[a][i * 4 + b][1] & 0xffff0000u) * acc[a][b][3];
        }
    }
    const int lane = rtid() & 63, wid = rtid() >> 6, lq = lane >> 4, lc = lane & 15;
#pragma unroll
    for (int a = 0; a < 2; ++a)
#pragma unroll
      for (int j = 0; j < 4; ++j) {
        const int tok = mt * 256 + wid * 32 + a * 16 + lq * 4 + j;
        u16* d = merged + (size_t)tok * 1024 + nt * 64 + lc;
        d[0] = f2bf(tot[a][0][j]); d[16] = f2bf(tot[a][1][j]); d[32] = f2bf(tot[a][2][j]); d[48] = f2bf(tot[a][3][j]);
      }
  }
}

#define PAN_WORD(c_, mt_) (3456 + ((c_) * 48 + (mt_)) * 64)
#define BAR_TOTAL_WORDS (3456 + 4 * 48 * 64)
DI void phase_res(const Params& p, int l, int which, char* smem, int bid, int nb) {
  const u16* A = which == 0 ? p.scan : p.proj; const int lda = which == 0 ? 1024 : 2816;
  const u16* B = which == 0 ? p.WoT : p.WdT; const int K = lda;
  const bool from_in = (l == 0 && which == 0);
  const bool has_next = (which == 0) || (l + 1 < 2);
  for (int it0 = bid; it0 < ((nb >> 3) * 8); it0 += nb) {
    const int per = 192 / 8, j = it0 >> 3;
    if (j >= per) {
      if (l == 0) {
        const int half = __builtin_amdgcn_readfirstlane((int)(threadIdx.x >> 8));
        const int vb = ((it0 & 7) + 8 * (j - per)) * 2 + half, vn = ((nb >> 3) - per) * 16;
        const int lo = which == 0 ? 0 : 1024, hi = which == 0 ? 1024 : 3968;
        for (int ci = lo + vb; ci < hi; ci += vn) conv_item(p, 1, ci, smem + half * 65536);
        if (which == 1) for (int ci = 4672 + vb; ci < N_CONV_ITEMS; ci += vn) conv_item(p, 1, ci, smem + half * 65536);
      }
      continue;
    }
    const int it = (it0 & 7) * per + j;
    int mt, nt; tile_mn(it, 48, 4, mt, nt);
    f32x4 acc[8][4]; zero_acc<8>(acc);
    gemm_main<8, true>(acc, A, lda, mt * 256, NTOK - 1, B, K, nt * 256, K, smem);
    const int tid = rtid(), lane = tid & 63, wid = tid >> 6, wm = wid >> 2, wn = wid & 3, lq = lane >> 4, lc = lane & 15;
    const int row0 = mt * 256;
    const int cv = tok_cv(row0);
    const float* xt = from_in ? (row0 < 4096 ? p.x_prompt + (size_t)row0 * 1024 : p.x_sample + (size_t)(row0 - 4096) * 1024) : p.out + (size_t)row0 * 1024;
    const int cb = nt * 256 + wn * 64 + lq * 4;
    float* sRed = reinterpret_cast<float*>(smem);
    {
      const GAS f32x4* gm = (const GAS f32x4*)(p.mod + (l * 3 + cv) * 6144 + (which ? 5120 : 2048) + cb);
      f32x4 gv[4];
#pragma unroll
      for (int b = 0; b < 4; ++b) gv[b] = gm[b * 4];
#pragma unroll
      for (int a2 = 0; a2 < 4; ++a2) {
        int rloc = wm * 128 + a2 * 32 + lc;
        asm volatile("" : "+v"(rloc));
        f32x4 xv[2][4];
#pragma unroll
        for (int h2 = 0; h2 < 2; ++h2)
#pragma unroll
          for (int b = 0; b < 4; ++b) xv[h2][b] = *(const GAS f32x4*)(xt + (size_t)(rloc + h2 * 16) * 1024 + cb + b * 16);
#pragma unroll
        for (int h2 = 0; h2 < 2; ++h2) {
          const int a = a2 * 2 + h2;
          float s = 0.f, ss = 0.f;
#pragma unroll
          for (int b = 0; b < 4; ++b)
#pragma unroll
            for (int jj = 0; jj < 4; ++jj) { const float v = ALPHA_F * xv[h2][b][jj] + gv[b][jj] * acc[a][b][jj]; acc[a][b][jj] = v; s += v; ss += v * v; }
          s += __shfl_xor(s, 16); ss += __shfl_xor(ss, 16);
          s += __shfl_xor(s, 32); ss += __shfl_xor(ss, 32);
          if (lq == 0) { sRed[((rloc + h2 * 16) * 4 + wn) * 2] = s; sRed[((rloc + h2 * 16) * 4 + wn) * 2 + 1] = ss; }
        }
        __builtin_amdgcn_sched_barrier(0);
      }
    }
    __syncthreads();
    if (tid < 256) {
      const f32x4 u0 = *reinterpret_cast<const f32x4*>(sRed + tid * 8), u1 = *reinterpret_cast<const f32x4*>(sRed + tid * 8 + 4);
      float* sp = p.stats + ((size_t)(row0 + tid) * 4 + nt) * 2;
      sp[0] = u0[0] + u0[2] + u1[0] + u1[2]; sp[1] = u0[1] + u0[3] + u1[1] + u1[3];
    }
    asm volatile("s_waitcnt vmcnt(0)" ::: "memory");
    __syncthreads();
    if (tid == 0) {
      unsigned* cnt = p.bar + PAN_WORD(l * 2 + which, mt);
      __builtin_amdgcn_fence(__ATOMIC_RELEASE, "agent");
      asm volatile("s_waitcnt vmcnt(0)" ::: "memory");
      (void)__hip_atomic_fetch_add(cnt, 1u, __ATOMIC_RELAXED, __HIP_MEMORY_SCOPE_AGENT);
      unsigned sp_ = 0;
      while (__hip_atomic_load(cnt, __ATOMIC_RELAXED, __HIP_MEMORY_SCOPE_AGENT) < 4u && sp_ < (1u << 22)) { __builtin_amdgcn_s_sleep(1); ++sp_; }
      __builtin_amdgcn_fence(__ATOMIC_ACQUIRE, "agent");
      asm volatile("s_waitcnt vmcnt(0)" ::: "memory");
    }
    __syncthreads();
    {
      const float* lg = p.ln_g + (l * 2 + which) * 1024 + cb; const float* lb = p.ln_b + (l * 2 + which) * 1024 + cb;
      const float* md = (which == 0 ? p.mod + (l * 3 + cv) * 6144 + 3072 : p.mod + ((l + 1 < 2 ? l + 1 : l) * 3 + cv) * 6144) + cb;
#pragma unroll
      for (int a2 = 0; a2 < 4; ++a2) {
        int rloc = wm * 128 + a2 * 32 + lc;
        asm volatile("" : "+v"(rloc));
#pragma unroll
        for (int h2 = 0; h2 < 2; ++h2) {
          const int a = a2 * 2 + h2; const int row = row0 + rloc + h2 * 16;
          const f32x4 t0 = *(const GAS f32x4*)(p.stats + (size_t)row * 8), t1 = *(const GAS f32x4*)(p.stats + (size_t)row * 8 + 4);
          const float s = t0[0] + t0[2] + t1[0] + t1[2], ss = t0[1] + t0[3] + t1[1] + t1[3];
          const float mean = s * (1.f / 1024.f); const float var = fmaxf(ss * (1.f / 1024.f) - mean * mean, 0.f); const float rstd = rsqrtf(var + EPS_F);
#pragma unroll
          for (int b = 0; b < 4; ++b) {
            const f32x4 g4 = *(const GAS f32x4*)(lg + b * 16), b4 = *(const GAS f32x4*)(lb + b * 16);
            f32x4 x;
#pragma unroll
            for (int jj = 0; jj < 4; ++jj) x[jj] = (acc[a][b][jj] - mean) * rstd * g4[jj] + b4[jj];
            *(GAS f32x4*)(p.out + (size_t)row * 1024 + cb + b * 16) = x;
            if (has_next) {
              const f32x4 sh = *(const GAS f32x4*)(md + b * 16), sc = *(const GAS f32x4*)(md + 1024 + b * 16);
              uint2 o; o.x = pack2(x[0] * (1.f + sc[0]) + sh[0], x[1] * (1.f + sc[1]) + sh[1]); o.y = pack2(x[2] * (1.f + sc[2]) + sh[2], x[3] * (1.f + sc[3]) + sh[3]);
              *reinterpret_cast<uint2*>(p.h + (size_t)row * 1024 + cb + b * 16) = o;
            }
          }
        }
        __builtin_amdgcn_sched_barrier(0);
      }
    }
    __syncthreads();
  }
}

DI void phase_ln(const Params& p, int l, int which, char* smem, int bid, int nb) {
  const int lane = tidx() & 63, wid = tidx() >> 6;
  const bool has_next = (which == 0) || (l + 1 < 2);
  f32x4 gvv[4], bvv[4];
#pragma unroll
  for (int it = 0; it < 4; ++it) {
    gvv[it] = *(const GAS f32x4*)(p.ln_g + (l * 2 + which) * 1024 + it * 256 + lane * 4);
    bvv[it] = *(const GAS f32x4*)(p.ln_b + (l * 2 + which) * 1024 + it * 256 + lane * 4);
  }
  for (int row = bid * 4 + wid; row < NTOK; row += nb * 4) {
    float s = 0.f, ss = 0.f;
    if (lane < 16) { const float* sp = p.stats + ((size_t)row * 16 + lane) * 2; s = sp[0]; ss = sp[1]; }
    const float* md = which == 0 ? p.mod + (l * 3 + tok_cv(row)) * 6144 + 3072 : p.mod + ((l + 1 < 2 ? l + 1 : l) * 3 + tok_cv(row)) * 6144;
    float* xr = p.out + (size_t)row * 1024;
    f32x4 vin[4], shv[4], scv[4];
#pragma unroll
    for (int it = 0; it < 4; ++it) {
      vin[it] = *(const GAS f32x4*)(xr + it * 256 + lane * 4);
      shv[it] = *(const GAS f32x4*)(md + it * 256 + lane * 4);
      scv[it] = *(const GAS f32x4*)(md + 1024 + it * 256 + lane * 4);
    }
#pragma unroll
    for (int m = 1; m < 16; m <<= 1) { s += __shfl_xor(s, m); ss += __shfl_xor(ss, m); }
    s = __shfl(s, 0); ss = __shfl(ss, 0);
    const float mean = s * (1.f / 1024.f); const float var = fmaxf(ss * (1.f / 1024.f) - mean * mean, 0.f); const float rstd = rsqrtf(var + EPS_F);
#pragma unroll
    for (int it = 0; it < 4; ++it) {
      const int col = it * 256 + lane * 4;
      f32x4 v;
#pragma unroll
      for (int e = 0; e < 4; ++e) v[e] = (vin[it][e] - mean) * rstd * gvv[it][e] + bvv[it][e];
      *(GAS f32x4*)(xr + col) = v;
      if (has_next) {
        uint2 o; o.x = pack2(v[0] * (1.f + scv[it][0]) + shv[it][0], v[1] * (1.f + scv[it][1]) + shv[it][1]);
        o.y = pack2(v[2] * (1.f + scv[it][2]) + shv[it][2], v[3] * (1.f + scv[it][3]) + shv[it][3]);
        *reinterpret_cast<uint2*>(p.h + (size_t)row * 1024 + col) = o;
      }
    }
  }
  if (which == 1 && l == 0) {
    for (int it = bid; it < N_CONV_ITEMS; it += nb) conv_item(p, 1, it, smem);
  }
}

DI void phase_p5(const Params& p, int l, char* smem, int bid, int nb) {
  u16* U = p.proj;
  float* sA = reinterpret_cast<float*>(smem);
  const int ntiles = 49 * 22;
  for (int k = 0;; ++k) {
    const int it = xcd_tile(k, bid, nb);
    if (k * nb >= ntiles) break;
    if (it >= ntiles) continue;
    int mt, nt; tile_mn(it, 49, 22, mt, nt);
    const int g0 = mt * 254 - 1;
    f32x4 acc[8][4]; zero_acc<8>(acc);
    gemm_main<8>(acc, p.h, 1024, g0, NTOK - 1, p.WupT, 1024, nt * 256, 1024, smem);
    const int tid = rtid(), lane = tid & 63, wid = tid >> 6, wm = wid >> 2, wn = wid & 3, lq = lane >> 4, lc = lane & 15;
    float* sbase = sA + (wm * 128 + lq * 4) * 128 + (wn & 1) * 64 + lc;
    if (wn < 2) {
#pragma unroll
      for (int a = 0; a < 8; ++a)
#pragma unroll
        for (int b = 0; b < 4; ++b)
#pragma unroll
          for (int j = 0; j < 4; ++j) sbase[a * 2048 + j * 128 + b * 16] = acc[a][b][j];
    }
    __syncthreads();
    if (wn >= 2) {
      float w0[4], w1[4], w2[4], cbv[4];
#pragma unroll
      for (int b = 0; b < 4; ++b) { const int ch = nt * 128 + (wn - 2) * 64 + b * 16 + lc;
        w0[b] = p.ffn_conv_w[(l * 3 + 0) * 2816 + ch]; w1[b] = p.ffn_conv_w[(l * 3 + 1) * 2816 + ch]; w2[b] = p.ffn_conv_w[(l * 3 + 2) * 2816 + ch]; cbv[b] = p.ffn_conv_b[l * 2816 + ch]; }
      u16* ub = U + nt * 128 + (wn - 2) * 64 + lc;
#pragma unroll
      for (int a = 0; a < 8; ++a) {
#pragma unroll
        for (int j = 0; j < 4; ++j) {
          const int r = wm * 128 + a * 16 + lq * 4 + j; const int g = g0 + r;
          if (r >= 1 && r <= 254 && g < NTOK) {
            const bool st = g < 4096 ? ((g & 255) == 0) : ((g & 4095) == 0);
            const bool en = g < 4096 ? ((g & 255) == 255) : ((g & 4095) == 4095);
#pragma unroll
            for (int b = 0; b < 4; ++b) {
              const float* sp = sbase + a * 2048 + j * 128 + b * 16;
              const float ap = st ? 0.f : sp[-128];
              const float ac = sp[0];
              const float an = en ? 0.f : sp[128];
              const float cv = ap * w0[b] + ac * w1[b] + an * w2[b] + cbv[b];
              ub[(size_t)g * 2816 + b * 16] = f2bf(geluf_(cv) * acc[a][b][j]);
            }
          }
        }
        __builtin_amdgcn_sched_barrier(0);
      }
    }
    __syncthreads();
  }
}

DI void run_phase(int ph, char* smem_all, int rbid, int rnb) {
  const int half = __builtin_amdgcn_readfirstlane((int)(threadIdx.x >> 8));
  char* smem = smem_all + half * 65536; const int bid = rbid * 2 + half, nb = rnb * 2;
  unsigned long long ka = (unsigned long long)__builtin_amdgcn_kernarg_segment_ptr();
  asm volatile("" : "+s"(ka));
  const __attribute__((address_space(4))) Params& pk = *reinterpret_cast<const __attribute__((address_space(4))) Params*>(ka);
  Params p;
  p.x_prompt = (const float*)(const __attribute__((address_space(1))) float*)pk.x_prompt;
  p.x_sample = (const float*)(const __attribute__((address_space(1))) float*)pk.x_sample;
  p.cache_k = (const float*)(const __attribute__((address_space(1))) float*)pk.cache_k;
  p.cache_v = (const float*)(const __attribute__((address_space(1))) float*)pk.cache_v;
  p.state_ret = (const float*)(const __attribute__((address_space(1))) float*)pk.state_ret;
  p.state_gla = (const float*)(const __attribute__((address_space(1))) float*)pk.state_gla;
  p.c = (const float*)(const __attribute__((address_space(1))) float*)pk.c;
  p.c_ctx = (const float*)(const __attribute__((address_space(1))) float*)pk.c_ctx;
  p.ada_w = (const float*)(const __attribute__((address_space(1))) float*)pk.ada_w;
  p.ada_b = (const float*)(const __attribute__((address_space(1))) float*)pk.ada_b;
  p.w_in = (const float*)(const __attribute__((address_space(1))) float*)pk.w_in;
  p.ret_decay = (const float*)(const __attribute__((address_space(1))) float*)pk.ret_decay;
  p.gla_wa1 = (const float*)(const __attribute__((address_space(1))) float*)pk.gla_wa1;
  p.gla_wa2 = (const float*)(const __attribute__((address_space(1))) float*)pk.gla_wa2;
  p.gla_ba = (const float*)(const __attribute__((address_space(1))) float*)pk.gla_ba;
  p.gla_norm_g = (const float*)(const __attribute__((address_space(1))) float*)pk.gla_norm_g;
  p.diff_lam = (const float*)(const __attribute__((address_space(1))) float*)pk.diff_lam;
  p.diff_subln_g = (const float*)(const __attribute__((address_space(1))) float*)pk.diff_subln_g;
  p.w_branch = (const float*)(const __attribute__((address_space(1))) float*)pk.w_branch;
  p.w_out = (const float*)(const __attribute__((address_space(1))) float*)pk.w_out;
  p.ln_g = (const float*)(const __attribute__((address_space(1))) float*)pk.ln_g;
  p.ln_b = (const float*)(const __attribute__((address_space(1))) float*)pk.ln_b;
  p.ffn_w_up = (const float*)(const __attribute__((address_space(1))) float*)pk.ffn_w_up;
  p.ffn_conv_w = (const float*)(const __attribute__((address_space(1))) float*)pk.ffn_conv_w;
  p.ffn_conv_b = (const float*)(const __attribute__((address_space(1))) float*)pk.ffn_conv_b;
  p.ffn_w_down = (const float*)(const __attribute__((address_space(1))) float*)pk.ffn_w_down;
  p.out = (float*)(__attribute__((address_space(1))) float*)pk.out;
  p.dec = (float*)(__attribute__((address_space(1))) float*)pk.dec;
  p.r = (float*)(__attribute__((address_space(1))) float*)pk.r;
  p.stats = (float*)(__attribute__((address_space(1))) float*)pk.stats;
  p.mod = (float*)(__attribute__((address_space(1))) float*)pk.mod;
  p.rope = (float*)(__attribute__((address_space(1))) float*)pk.rope;
  p.lam = (float*)(__attribute__((address_space(1))) float*)pk.lam;
  p.WinT = (u16*)(__attribute__((address_space(1))) u16*)pk.WinT;
  p.WbT = (u16*)(__attribute__((address_space(1))) u16*)pk.WbT;
  p.WoT = (u16*)(__attribute__((address_space(1))) u16*)pk.WoT;
  p.WupT = (u16*)(__attribute__((address_space(1))) u16*)pk.WupT;
  p.WdT = (u16*)(__attribute__((address_space(1))) u16*)pk.WdT;
  p.proj = (u16*)(__attribute__((address_space(1))) u16*)pk.proj;
  p.Kc_p = (u16*)(__attribute__((address_space(1))) u16*)pk.Kc_p;
  p.VcT_p = (u16*)(__attribute__((address_space(1))) u16*)pk.VcT_p;
  p.Kc_s = (u16*)(__attribute__((address_space(1))) u16*)pk.Kc_s;
  p.VcT_s = (u16*)(__attribute__((address_space(1))) u16*)pk.VcT_s;
  p.h = (u16*)(__attribute__((address_space(1))) u16*)pk.h;
  p.scan = (u16*)(__attribute__((address_space(1))) u16*)pk.scan;
  p.bar = (unsigned*)(__attribute__((address_space(1))) unsigned*)pk.bar;
  if (ph == 0) { phase_pr0(p, smem, bid, nb); return; }
  if (ph == 1) { phase_pr1(p, bid, nb); return; }
  const int l = (ph - 2) / 10;
#ifdef ONLYS
  const int s = ONLYS;
#else
  const int s = (ph - 2) % 10;
#endif
  switch (s) {
    case 0: phase_p1(p, l, smem_all, rbid, rnb, bid, nb); break;
    case 1: phase_p2a(p, l, smem, bid, nb); break;
    case 2: phase_p2b(p, l, bid, nb);
      if (l == 1) { for (int it = 3968 + bid; it < 4672; it += nb) conv_item(p, 1, it, smem); }
      break;
    case 3: phase_p2c(p, l, smem_all, smem, rbid, rnb, bid, nb); break;
    case 4: phase_p3(p, l, smem_all, rbid, rnb); break;
    case 5: phase_res(p, l, 0, smem_all, rbid, rnb); break;
    case 6: break;
    case 7: phase_p5(p, l, smem_all, rbid, rnb); break;
    case 8: phase_res(p, l, 1, smem_all, rbid, rnb); break;
    default: break;
  }
}

#define XB_TMO      128
#define XB_XCNT(j)  (256  + 64 * (j))
#define XB_XSUB(j)  (1280 + 64 * (j))
#define XB_XGEN(j)  (2304 + 64 * (j))
#define XB_TOP      3328
#define XB_TOPGEN   3392
#define XCD_BAR_WORDS 3456
#define XB_SPIN_CAP (1u << 22)
#define LAS __attribute__((address_space(3)))
DI unsigned xb_ld(unsigned* p)              { return __hip_atomic_load(p, __ATOMIC_RELAXED, __HIP_MEMORY_SCOPE_AGENT); }
DI unsigned xb_add(unsigned* p, unsigned v) { return __hip_atomic_fetch_add(p, v, __ATOMIC_RELAXED, __HIP_MEMORY_SCOPE_AGENT); }
DI unsigned xb_xcc_id() { return (unsigned)__builtin_amdgcn_s_getreg((3 << 11) | 20) & 0xFu; }
#define XB_SPIN(cond, bar) do { unsigned _sp = 0; while (cond) { __builtin_amdgcn_s_sleep(1); \
    if ((++_sp & 255u) == 0u) { if (xb_ld(&(bar)[XB_TMO])) break; if (_sp > XB_SPIN_CAP) { atomicAdd(&(bar)[XB_TMO], 1u); break; } } } } while (0)
struct XcdBarrier { unsigned* bar; unsigned x; volatile LAS unsigned* st; };
DI XcdBarrier xcd_barrier_post(unsigned* bar, volatile LAS unsigned* st) {
  XcdBarrier b; b.bar = bar; b.x = xb_xcc_id(); b.st = st;
  if (threadIdx.x == 0) (void)xb_add(&bar[XB_XCNT(b.x)], 1u);
  return b;
}
DI void xcd_barrier_complete(unsigned* bar, unsigned x, unsigned& nloc, unsigned& nx) {
  const unsigned G = gridDim.x * gridDim.y * gridDim.z;
  unsigned sum, cnt, mine, sp = 0u;
  for (;;) {
    sum = 0u; cnt = 0u; mine = 0u;
#pragma unroll
    for (unsigned j = 0; j < 16; ++j) { const unsigned c = xb_ld(&bar[XB_XCNT(j)]); sum += c; cnt += (c > 0u) ? 1u : 0u; mine = (j == x) ? c : mine; }
    if (sum == G) break;
    __builtin_amdgcn_s_sleep(1);
    if ((++sp & 255u) == 0u) { if (xb_ld(&bar[XB_TMO])) break; if (sp > XB_SPIN_CAP) { atomicAdd(&bar[XB_TMO], 1u); break; } }
  }
  nloc = mine > 0u ? mine : 1u; nx = cnt > 0u ? cnt : 1u;
}
DI void xcd_barrier(const XcdBarrier& b) {
  asm volatile("s_waitcnt vmcnt(0)" ::: "memory");
  __syncthreads();
  if (threadIdx.x == 0) {
    unsigned* bar = b.bar;
    __builtin_amdgcn_s_waitcnt(0);
    unsigned nloc = b.st[0], nx = b.st[1];
    if (nloc == 0u) { xcd_barrier_complete(bar, b.x, nloc, nx); b.st[0] = nloc; b.st[1] = nx; }
    const unsigned old = xb_add(&bar[XB_XSUB(b.x)], 1u);
    const unsigned gen = old / nloc;
    if (old + 1u == (gen + 1u) * nloc) {
      __builtin_amdgcn_fence(__ATOMIC_RELEASE, "agent");
      asm volatile("s_waitcnt vmcnt(0)" ::: "memory");
      const unsigned og = xb_add(&bar[XB_TOP], 1u);
      const unsigned tg = og / nx;
      if (og + 1u == (tg + 1u) * nx) xb_add(&bar[XB_TOPGEN], 1u);
      else XB_SPIN(xb_ld(&bar[XB_TOPGEN]) == tg, bar);
      __builtin_amdgcn_fence(__ATOMIC_ACQUIRE, "agent");
      xb_add(&bar[XB_XGEN(b.x)], 1u);
      asm volatile("s_waitcnt vmcnt(0)" ::: "memory");
    } else {
      XB_SPIN(xb_ld(&bar[XB_XGEN(b.x)]) == gen, bar);
      __builtin_amdgcn_fence(__ATOMIC_ACQUIRE, "agent");
      asm volatile("s_waitcnt vmcnt(0)" ::: "memory");
    }
  }
  __syncthreads();
}

#define N_PHASES 22

__global__ void __launch_bounds__(512, 2) k_mega(Params p) {
  extern __shared__ __attribute__((aligned(16))) char smem[];
  __shared__ uint4 xb_words;
  cg::grid_group grid = cg::this_grid();
  if (threadIdx.x == 0) xb_words = make_uint4(0u, 0u, 0u, 0u);
  __syncthreads();
  XcdBarrier xb = xcd_barrier_post(p.bar, (volatile LAS unsigned*)&xb_words);
#define RUNPH(n_) do { int bid_ = blockIdx.x, nb_ = gridDim.x; asm volatile("" : "+s"(bid_), "+s"(nb_)); run_phase(n_, smem, bid_, nb_); } while (0)
#define GSYNC() xcd_barrier(xb)
  RUNPH(0); if (p.bar == nullptr) grid.sync(); else GSYNC(); RUNPH(1); GSYNC();
  RUNPH(2); GSYNC(); RUNPH(3); GSYNC(); RUNPH(4); GSYNC(); RUNPH(5); GSYNC(); RUNPH(6); GSYNC();
  RUNPH(7); GSYNC(); RUNPH(9); GSYNC(); RUNPH(10); GSYNC();
  RUNPH(12); GSYNC(); RUNPH(13); GSYNC(); RUNPH(14); GSYNC(); RUNPH(15); GSYNC(); RUNPH(16); GSYNC();
  RUNPH(17); GSYNC(); RUNPH(19); GSYNC(); RUNPH(20);
}

extern "C" void kernel_launch(void* const* d_in, const int* in_sizes, int n_in, void* d_out, int out_size, void* d_ws, size_t ws_size, hipStream_t stream) {
  (void)in_sizes; (void)n_in; (void)out_size;
  Params p{};
  const float** f = reinterpret_cast<const float**>(&p);
  for (int i = 0; i < 26; ++i) f[i] = (const float*)d_in[i];
  p.out = (float*)d_out;
  char* w = (char*)d_ws; size_t off = 0;
  auto take = [&](size_t bytes) { char* r = w + off; off += (bytes + 255) & ~(size_t)255; return r; };
  p.WinT = (u16*)take((size_t)7936 * 1024 * 2);
  p.WbT = (u16*)take((size_t)3 * 1024 * 512 * 2);
  p.WoT = (u16*)take((size_t)1024 * 1024 * 2);
  p.WupT = (u16*)take((size_t)5632 * 1024 * 2);
  p.WdT = (u16*)take((size_t)1024 * 2816 * 2);
  p.proj = (u16*)take((size_t)NTOK * PLD * 2);
  p.Kc_p = (u16*)take((size_t)16 * 8 * 256 * 64 * 2);
  p.VcT_p = (u16*)take((size_t)16 * 4 * 128 * 256 * 2);
  p.Kc_s = (u16*)take((size_t)2 * 8 * 4352 * 64 * 2);
  p.VcT_s = (u16*)take((size_t)2 * 4 * 128 * 4352 * 2);
  p.h = (u16*)take((size_t)NTOK * 1024 * 2);
  p.scan = (u16*)take((size_t)2 * SCAN_MIX_ELEMS * 2);
  p.dec = (float*)take((size_t)2 * DEC_MIX * 4);
  p.r = (float*)take((size_t)NTOK * 32 * 4);
  p.stats = (float*)take((size_t)NTOK * 16 * 2 * 4);
  p.mod = (float*)take((size_t)2 * 3 * 6144 * 4);
  p.rope = (float*)take((size_t)64 * 16 * 2 * 4);
  p.lam = (float*)take(256);
  p.bar = (unsigned*)take((size_t)BAR_TOTAL_WORDS * 4);
  if (off > ws_size) { fprintf(stderr, "workspace too small: need %zu have %zu\n", off, ws_size); return; }
  constexpr size_t kDynLds = 131072;
  static int grid_blocks = 0;
  if (!grid_blocks) {
    int dev = 0, cus = 0, per_cu = 0;
    (void)hipGetDevice(&dev);
    (void)hipDeviceGetAttribute(&cus, hipDeviceAttributeMultiprocessorCount, dev);
    (void)hipFuncSetAttribute((const void*)k_mega, hipFuncAttributeMaxDynamicSharedMemorySize, (int)kDynLds);
    (void)hipOccupancyMaxActiveBlocksPerMultiprocessor(&per_cu, k_mega, 512, kDynLds);
    if (per_cu > 1) per_cu = 1;
    grid_blocks = cus * per_cu;
    grid_blocks &= ~7;
  }
  (void)hipMemsetAsync(p.bar, 0, (size_t)BAR_TOTAL_WORDS * 4, stream);
  void* args[] = {&p};
  hipError_t e = hipLaunchCooperativeKernel((void*)k_mega, dim3(grid_blocks), dim3(512), args, kDynLds, stream);
  if (e != hipSuccess) fprintf(stderr, "cooperative launch failed: %s (grid %d)\n", hipGetErrorString(e), grid_blocks);
}
```

```cpp
#include <hip/hip_runtime.h>
#include <hip/hip_cooperative_groups.h>
#include <cstdio>
namespace cg = cooperative_groups;

#ifndef MULTI_LAUNCH
#define MULTI_LAUNCH 0
#endif

typedef unsigned short u16;
using bf16x8 = __attribute__((ext_vector_type(8))) short;
using s16x4  = __attribute__((ext_vector_type(4))) short;
using f32x4  = __attribute__((ext_vector_type(4))) float;
using f32x16 = __attribute__((ext_vector_type(16))) float;
#define DI __device__ __forceinline__
#define GAS __attribute__((address_space(1)))
typedef const GAS unsigned short* gcu16p;
typedef unsigned u32x4 __attribute__((ext_vector_type(4)));
typedef const GAS u32x4* gcu4p;

#define NTOK 12288
#define PLD 3584
#define ALPHA_F 1.4142135623730951f
#define EPS_F 1e-5f
#define LOG2E_F 1.4426950408889634f

#define OUT_YS   4194304
#define OUT_DK   12582912
#define OUT_DV   16777216
#define OUT_SRET 20971520
#define OUT_SGLA 23068672

#define SCAN_MIX_ELEMS 12582912
#define SCAN_SAMPLE_OFF 4194304
#define DEC_MIX 98304
#define DEC_SAMPLE_OFF 32768

struct Params {
  const float *x_prompt, *x_sample, *cache_k, *cache_v, *state_ret, *state_gla, *c, *c_ctx;
  const float *ada_w, *ada_b, *w_in, *ret_decay, *gla_wa1, *gla_wa2, *gla_ba, *gla_norm_g, *diff_lam,
      *diff_subln_g, *w_branch, *w_out, *ln_g, *ln_b, *ffn_w_up, *ffn_conv_w, *ffn_conv_b, *ffn_w_down;
  float* out;
  u16 *WinT, *WbT, *WoT, *WupT, *WdT;
  u16 *proj, *Kc_p, *VcT_p, *Kc_s, *VcT_s, *h, *scan;
  float *dec, *r, *stats, *mod, *rope, *lam;
  unsigned* bar;
};

DI int rtid() { int t = __builtin_amdgcn_workitem_id_x(); asm volatile("" : "+v"(t)); return t; }
DI int tidx() { int t = __builtin_amdgcn_workitem_id_x() & 255; asm volatile("" : "+v"(t)); return t; }
typedef __bf16 bf2_t __attribute__((ext_vector_type(2)));
typedef float f2_t __attribute__((ext_vector_type(2)));
DI unsigned pack2(float a, float b) { f2_t v = {a, b}; return __builtin_bit_cast(unsigned, __builtin_convertvector(v, bf2_t)); }
DI u16 f2bf(float x) { return (u16)(pack2(x, 0.f) & 0xffffu); }
DI float bf2f(u16 b) { return __uint_as_float(((unsigned)b) << 16); }
DI float sigmoidf_(float x) { return __builtin_amdgcn_rcpf(1.f + __expf(-x)); }
DI float siluf_(float x) { return x * __builtin_amdgcn_rcpf(1.f + __expf(-x)); }
DI float logsigf_(float z) { return fminf(z, 0.f) - __logf(1.f + __expf(-fabsf(z))); }
DI float geluf_(float x) { float y = 0.7978845608028654f * (x + 0.044715f * x * x * x); float t = 1.f - 2.f * __builtin_amdgcn_rcpf(1.f + __expf(2.f * y)); return 0.5f * x * (1.f + t); }
DI int tok_cv(int tok) { return tok < 4096 ? 0 : 1 + ((tok - 4096) >> 12); }
DI f32x4 zero4() { f32x4 z = {0.f, 0.f, 0.f, 0.f}; return z; }
#define MFMA16(a, b, c) __builtin_amdgcn_mfma_f32_16x16x32_bf16((a), (b), (c), 0, 0, 0)
#define MFMA32(a, b, c) __builtin_amdgcn_mfma_f32_32x32x16_bf16((a), (b), (c), 0, 0, 0)

struct GemmNext { const u16* A; int lda; const u16* B; int ldb; int n0; int bcs; int nbc; int m0; };
template <int MI, bool TR = false, int NJ = 4, bool PRE = false, bool NEXT = false>
DI void gemm_main(f32x4 (&acc)[MI][NJ], const u16* __restrict__ A, int lda, int m0, int mmax,
                  const u16* __restrict__ B, int ldb, int n0, int K, char* smem, int bcs = 64, GemmNext nx = GemmNext{}) {
  constexpr int NBC = MI == 8 ? 4 : (MI == 4 ? 2 : NJ / 4);
  const int tid = rtid(), lane = tid & 63, wid = tid >> 6;
  const int wro = MI == 8 ? (wid >> 2) * 128 : (MI == 4 ? (wid >> 1) * 64 : wid * 32);
  const int wco = MI == 8 ? (wid & 3) * 64 : (MI == 4 ? (wid & 1) * 64 : 0);
  const int lr = tid >> 3, lch = tid & 7;
  size_t aoff0, aoff1, aoff2, aoff3;
  { int r = m0 + lr; r = r < 0 ? 0 : (r > mmax ? mmax : r); aoff0 = (size_t)r * lda + lch * 8; }
  { int r = m0 + lr + 64; r = r < 0 ? 0 : (r > mmax ? mmax : r); aoff1 = (size_t)r * lda + lch * 8; }
  { int r = m0 + lr + 128; r = r < 0 ? 0 : (r > mmax ? mmax : r); aoff2 = (size_t)r * lda + lch * 8; }
  { int r = m0 + lr + 192; r = r < 0 ? 0 : (r > mmax ? mmax : r); aoff3 = (size_t)r * lda + lch * 8; }
  gcu16p Ag = (gcu16p)A;
  gcu16p bbase = (gcu16p)B + (size_t)(n0 + lr) * ldb + lch * 8;
  const int soff = lr * 128 + ((lch ^ ((lr >> 1) & 7)) << 4);
  const int lr16 = lane & 15, q = lane >> 4, swz = lr16 >> 1;
  const int c0 = ((q ^ swz) << 4);
  const int aro = (wro + lr16) * 128, bro = 32768 + (wco + lr16) * 128;
  u32x4 ra0, ra1, ra2, ra3, rb0, rb1, rb2, rb3;
  rb1 = (u32x4){0u, 0u, 0u, 0u}; rb2 = rb1; rb3 = rb1;
  const int nk = K >> 6;
#define G_LOAD(k0_) do { \
    ra0 = *(gcu4p)(Ag + aoff0 + (k0_)); ra1 = *(gcu4p)(Ag + aoff1 + (k0_)); \
    ra2 = *(gcu4p)(Ag + aoff2 + (k0_)); ra3 = *(gcu4p)(Ag + aoff3 + (k0_)); \
    rb0 = *(gcu4p)(bbase + (k0_)); \
    if (NBC >= 2) rb1 = *(gcu4p)(bbase + (size_t)bcs * ldb + (k0_)); \
    if (NBC >= 3) rb2 = *(gcu4p)(bbase + (size_t)(2 * bcs) * ldb + (k0_)); \
    if (NBC == 4) rb3 = *(gcu4p)(bbase + (size_t)(3 * bcs) * ldb + (k0_)); } while (0)
#define G_STORE(sw_) do { \
    *reinterpret_cast<u32x4*>((sw_) + soff) = ra0; *reinterpret_cast<u32x4*>((sw_) + soff + 8192) = ra1; \
    *reinterpret_cast<u32x4*>((sw_) + soff + 16384) = ra2; *reinterpret_cast<u32x4*>((sw_) + soff + 24576) = ra3; \
    *reinterpret_cast<u32x4*>((sw_) + 32768 + soff) = rb0; \
    if (NBC >= 2) *reinterpret_cast<u32x4*>((sw_) + 32768 + soff + 8192) = rb1; \
    if (NBC >= 3) *reinterpret_cast<u32x4*>((sw_) + 32768 + soff + 16384) = rb2; \
    if (NBC == 4) *reinterpret_cast<u32x4*>((sw_) + 32768 + soff + 24576) = rb3; } while (0)
#define LDA_(sb_, ks_, mi_) (*reinterpret_cast<const bf16x8*>((sb_) + aro + (mi_) * 2048 + (c0 ^ ((ks_) * 64))))
#define LDB_(sb_, ks_, ni_) (*reinterpret_cast<const bf16x8*>((sb_) + bro + (ni_) * 2048 + (c0 ^ ((ks_) * 64))))
#define G_SB() __builtin_amdgcn_sched_barrier(0)
#define G_STEP(sb_, s_) do { \
    if ((s_) + 3 < 16) ar[((s_) + 3) & 3] = LDA_(sb_, ((s_) + 3) >> 3, ((s_) + 3) & 7); \
    if ((s_) >= 4 && (s_) < 8) b1[((s_) - 4) & 3] = LDB_(sb_, 1, ((s_) - 4) & 3); \
    _Pragma("unroll") for (int ni = 0; ni < 4; ++ni) \
      acc[(s_) & (MI - 1)][ni] = TR ? MFMA16(((s_) >> 3) ? b1[ni] : b0[ni], ar[(s_) & 3], acc[(s_) & (MI - 1)][ni]) : MFMA16(ar[(s_) & 3], ((s_) >> 3) ? b1[ni] : b0[ni], acc[(s_) & (MI - 1)][ni]); \
    G_SB(); } while (0)
#define G_COMPUTE(sb_) do { \
    if (MI == 8) { \
      bf16x8 b0[4], b1[4], ar[4]; \
      _Pragma("unroll") for (int ni = 0; ni < 4; ++ni) b0[ni] = LDB_(sb_, 0, ni); \
      ar[0] = LDA_(sb_, 0, 0); ar[1] = LDA_(sb_, 0, 1); ar[2] = LDA_(sb_, 0, 2); \
      G_SB(); \
      G_STEP(sb_, 0); G_STEP(sb_, 1); G_STEP(sb_, 2); G_STEP(sb_, 3); G_STEP(sb_, 4); G_STEP(sb_, 5); G_STEP(sb_, 6); G_STEP(sb_, 7); \
      G_STEP(sb_, 8); G_STEP(sb_, 9); G_STEP(sb_, 10); G_STEP(sb_, 11); G_STEP(sb_, 12); G_STEP(sb_, 13); G_STEP(sb_, 14); G_STEP(sb_, 15); \
    } else if (NJ != 4) { \
      _Pragma("unroll") for (int ks = 0; ks < 2; ++ks) { \
        bf16x8 af2[MI]; \
        _Pragma("unroll") for (int mi = 0; mi < MI; ++mi) af2[mi] = LDA_(sb_, ks, mi); \
        _Pragma("unroll") for (int ni = 0; ni < NJ; ++ni) { \
          const bf16x8 bq = LDB_(sb_, ks, ni); \
          _Pragma("unroll") for (int mi = 0; mi < MI; ++mi) acc[mi][ni] = MFMA16(af2[mi], bq, acc[mi][ni]); } } \
    } else { \
      _Pragma("unroll") for (int ks = 0; ks < 2; ++ks) { \
        bf16x8 af[MI], bfr[4]; \
        _Pragma("unroll") for (int mi = 0; mi < MI; ++mi) af[mi] = LDA_(sb_, ks, mi); \
        _Pragma("unroll") for (int ni = 0; ni < 4; ++ni) bfr[ni] = LDB_(sb_, ks, ni); \
        _Pragma("unroll") for (int mi = 0; mi < MI; ++mi) \
          _Pragma("unroll") for (int ni = 0; ni < 4; ++ni) acc[mi][ni] = TR ? MFMA16(bfr[ni], af[mi], acc[mi][ni]) : MFMA16(af[mi], bfr[ni], acc[mi][ni]); } \
    } } while (0)
#define G_BAR() asm volatile("s_waitcnt lgkmcnt(0)\n\ts_barrier" ::: "memory")
  const int klast = K - 64;
#ifndef NO_GLDS
  {
    const int sw8 = ((lch ^ ((lr >> 1) & 7)) - lch) * 8;
    typedef __attribute__((address_space(3))) unsigned* ldsu;
    ldsu lbase = (ldsu)(smem) + wid * 256;
#define G_DMA(stage_, k0_) do { \
      ldsu lb_ = lbase + (stage_) * 16384; \
      __builtin_amdgcn_global_load_lds((const GAS unsigned*)(Ag + aoff0 + sw8 + (k0_)), lb_, 16, 0, 0); \
      __builtin_amdgcn_global_load_lds((const GAS unsigned*)(Ag + aoff1 + sw8 + (k0_)), lb_ + 2048, 16, 0, 0); \
      __builtin_amdgcn_global_load_lds((const GAS unsigned*)(Ag + aoff2 + sw8 + (k0_)), lb_ + 4096, 16, 0, 0); \
      __builtin_amdgcn_global_load_lds((const GAS unsigned*)(Ag + aoff3 + sw8 + (k0_)), lb_ + 6144, 16, 0, 0); \
      __builtin_amdgcn_global_load_lds((const GAS unsigned*)(bbase + sw8 + (k0_)), lb_ + 8192, 16, 0, 0); \
      if (NBC >= 2) __builtin_amdgcn_global_load_lds((const GAS unsigned*)(bbase + (size_t)bcs * ldb + sw8 + (k0_)), lb_ + 8192 + 2048, 16, 0, 0); \
      if (NBC >= 3) __builtin_amdgcn_global_load_lds((const GAS unsigned*)(bbase + (size_t)(2 * bcs) * ldb + sw8 + (k0_)), lb_ + 8192 + 4096, 16, 0, 0); \
      if (NBC == 4) __builtin_amdgcn_global_load_lds((const GAS unsigned*)(bbase + (size_t)(3 * bcs) * ldb + sw8 + (k0_)), lb_ + 8192 + 6144, 16, 0, 0); } while (0)
#define G_BARV() asm volatile("s_waitcnt vmcnt(0) lgkmcnt(0)\n\ts_barrier" ::: "memory")
    if (!PRE) { G_DMA(0, 0); G_BARV(); }
#pragma unroll 1
    for (int kt = 0; kt < nk; ++kt) {
      if (NEXT && kt == nk - 1) {
        gcu16p An = (gcu16p)nx.A; gcu16p Bn = (gcu16p)nx.B + (size_t)(nx.n0 + lr) * nx.ldb + lch * 8 + sw8;
        ldsu lb_ = lbase;
#define G_NROW(i_) ({ int r_ = nx.m0 + lr + 64 * (i_); r_ = r_ < 0 ? 0 : (r_ > mmax ? mmax : r_); (size_t)r_ * nx.lda + lch * 8 + sw8; })
        __builtin_amdgcn_global_load_lds((const GAS unsigned*)(An + G_NROW(0)), lb_, 16, 0, 0);
        __builtin_amdgcn_global_load_lds((const GAS unsigned*)(An + G_NROW(1)), lb_ + 2048, 16, 0, 0);
        __builtin_amdgcn_global_load_lds((const GAS unsigned*)(An + G_NROW(2)), lb_ + 4096, 16, 0, 0);
        __builtin_amdgcn_global_load_lds((const GAS unsigned*)(An + G_NROW(3)), lb_ + 6144, 16, 0, 0);
        __builtin_amdgcn_global_load_lds((const GAS unsigned*)(Bn), lb_ + 8192, 16, 0, 0);
        if (nx.nbc >= 2) __builtin_amdgcn_global_load_lds((const GAS unsigned*)(Bn + (size_t)nx.bcs * nx.ldb), lb_ + 8192 + 2048, 16, 0, 0);
        if (nx.nbc >= 3) __builtin_amdgcn_global_load_lds((const GAS unsigned*)(Bn + (size_t)(2 * nx.bcs) * nx.ldb), lb_ + 8192 + 4096, 16, 0, 0);
        if (nx.nbc >= 4) __builtin_amdgcn_global_load_lds((const GAS unsigned*)(Bn + (size_t)(3 * nx.bcs) * nx.ldb), lb_ + 8192 + 6144, 16, 0, 0);
      } else {
        int k1 = (kt + 1) << 6; k1 = k1 > klast ? klast : k1; G_DMA((kt + 1) & 1, k1);
      }
      G_COMPUTE(smem + (kt & 1) * 65536);
      G_BARV();
    }
    if (!NEXT) __syncthreads();
    return;
  }
#endif
  G_LOAD(0);
  G_STORE(smem);
  G_LOAD(64);
  __syncthreads();
#pragma unroll 1
  for (int kt = 0; kt < nk; ++kt) {
    const char* sb = smem + (kt & 1) * 65536;
    char* sw = smem + ((kt + 1) & 1) * 65536;
    G_COMPUTE(sb);
    G_STORE(sw);
    G_BAR();
    { int k2 = (kt + 2) << 6; k2 = k2 > klast ? klast : k2; G_LOAD(k2); }
  }
  __syncthreads();
}

DI int xcd_tile(int k, int bid, int nb) { const int per = nb >> 3; return (k * 8 + (bid & 7)) * per + (bid >> 3); }
DI void tile_mn(int L, int MT, int NT, int& mt, int& nt) {
  const int g = L / (8 * NT), w = L - g * 8 * NT; const int gsz = (MT - g * 8) < 8 ? (MT - g * 8) : 8;
  nt = w / gsz; mt = g * 8 + (w - nt * gsz);
}

template <int MI, int NJ = 4>
DI void zero_acc(f32x4 (&acc)[MI][NJ]) {
#pragma unroll
  for (int i = 0; i < MI; ++i)
#pragma unroll
    for (int j = 0; j < NJ; ++j) acc[i][j] = zero4();
}

DI void conv_tile(const float* __restrict__ src, int ldn, int c0, int k0, u16* __restrict__ dst, int ldk, int r0, char* smem) {
  float* t = reinterpret_cast<float*>(smem);
  const int tid = tidx();
#pragma unroll
  for (int it = 0; it < 16; ++it) { int idx = tid + 256 * it; int kk = idx >> 6, cc = idx & 63; t[kk * 65 + cc] = src[(size_t)(k0 + kk) * ldn + c0 + cc]; }
  __syncthreads();
#pragma unroll
  for (int it = 0; it < 2; ++it) {
    int ch = tid + 256 * it; int n = ch >> 3, kc = ch & 7;
    uint4 v;
    v.x = pack2(t[(kc * 8 + 0) * 65 + n], t[(kc * 8 + 1) * 65 + n]);
    v.y = pack2(t[(kc * 8 + 2) * 65 + n], t[(kc * 8 + 3) * 65 + n]);
    v.z = pack2(t[(kc * 8 + 4) * 65 + n], t[(kc * 8 + 5) * 65 + n]);
    v.w = pack2(t[(kc * 8 + 6) * 65 + n], t[(kc * 8 + 7) * 65 + n]);
    *reinterpret_cast<uint4*>(dst + (size_t)(r0 + n) * ldk + k0 + kc * 8) = v;
  }
  __syncthreads();
}

#define N_CONV_ITEMS 4800
DI void conv_item(const Params& p, int l, int it, char* smem) {
  if (it < 1920) { int nb = it >> 4, kb = it & 15; conv_tile(p.w_in + (size_t)l * 1024 * 7680, 7680, nb * 64, kb * 64, p.WinT, 1024, nb * 64, smem); return; }
  it -= 1920;
  if (it < 384) { int i = it >> 7, r = it & 127; int nb = r >> 3, kb = r & 7;
    conv_tile(p.w_branch + (size_t)(l * 3 + i) * 512 * 1024, 1024, nb * 64, kb * 64, p.WbT + (size_t)i * 1024 * 512, 512, nb * 64, smem); return; }
  it -= 384;
  if (it < 256) { int nb = it >> 4, kb = it & 15; conv_tile(p.w_out + (size_t)l * 1024 * 1024, 1024, nb * 64, kb * 64, p.WoT, 1024, nb * 64, smem); return; }
  it -= 256;
  if (it < 1408) { int nb = it >> 4, kb = it & 15; const int tl = nb >> 2, w = nb & 3; int c0 = w < 2 ? tl * 128 + w * 64 : 2816 + tl * 128 + (w - 2) * 64;
    conv_tile(p.ffn_w_up + (size_t)l * 1024 * 5632, 5632, c0, kb * 64, p.WupT, 1024, nb * 64, smem); return; }
  it -= 1408;
  if (it < 704) { int nb = it / 44, kb = it % 44; conv_tile(p.ffn_w_down + (size_t)l * 2816 * 1024, 1024, nb * 64, kb * 64, p.WdT, 2816, nb * 64, smem); return; }
  it -= 704;
  for (int e = tidx(); e < 2048; e += 256) {
    int idx = it * 2048 + e; int row = idx >> 10, k = idx & 1023;
    float v = row < 32 ? p.gla_wa1[(((size_t)l * 2 + (row >> 4)) * 1024 + k) * 16 + (row & 15)] : 0.f;
    p.WinT[(size_t)(7680 + row) * 1024 + k] = f2bf(v);
  }
}

DI void ada_item(const Params& p, int it, char* smem) {
  const int l = it / 96, cb = it % 96, tid = tidx();
  float* ssil = reinterpret_cast<float*>(smem);
  float* red = ssil + 3072;
  for (int i = tid; i < 3072; i += 256) { int j = i >> 10, k = i & 1023; float v = j == 0 ? p.c_ctx[k] : p.c[(j - 1) * 1024 + k]; ssil[i] = siluf_(v); }
  __syncthreads();
  const int c = tid & 63, kg = tid >> 6;
  const float* w = p.ada_w + (size_t)l * 1024 * 6144 + cb * 64 + c;
  float a0 = 0.f, a1 = 0.f, a2 = 0.f;
#pragma unroll 32
  for (int k = kg * 256; k < kg * 256 + 256; ++k) { float wv = w[(size_t)k * 6144]; a0 += ssil[k] * wv; a1 += ssil[1024 + k] * wv; a2 += ssil[2048 + k] * wv; }
  red[(kg * 3 + 0) * 64 + c] = a0; red[(kg * 3 + 1) * 64 + c] = a1; red[(kg * 3 + 2) * 64 + c] = a2;
  __syncthreads();
  if (tid < 192) { int j = tid >> 6; float s = p.ada_b[l * 6144 + cb * 64 + c];
    for (int g = 0; g < 4; ++g) s += red[(g * 3 + j) * 64 + c];
    p.mod[(l * 3 + j) * 6144 + cb * 64 + c] = s; }
  __syncthreads();
}

DI void misc_item(const Params& p) {
  const int tid = tidx();
  if (tid < 16) {
    int a = tid >> 2, b = tid & 3;
    double th = (b == 0 ? 1.0 : b == 1 ? 0.5623413251903491 : b == 2 ? 0.31622776601683794 : 0.1778279410038923);
    th *= (a == 0 ? 1.0 : a == 1 ? 0.1 : a == 2 ? 0.01 : 0.001);
    double t2 = th * th, cs = 1.0, sn = th, tc = 1.0, ts = th;
    for (int n = 1; n < 14; ++n) { tc *= -t2 / ((2.0 * n - 1.0) * (2.0 * n)); cs += tc; ts *= -t2 / ((2.0 * n) * (2.0 * n + 1.0)); sn += ts; }
    double c = 1.0, s = 0.0;
    for (int pos = 0; pos < 64; ++pos) { p.rope[(pos * 16 + tid) * 2] = (float)c; p.rope[(pos * 16 + tid) * 2 + 1] = (float)s; double cn = c * cs - s * sn; s = s * cs + c * sn; c = cn; }
  } else if (tid == 32 || tid == 33) {
    int l = tid - 32; const float* lp = p.diff_lam + l * 256; float s1 = 0.f, s2 = 0.f;
    for (int d = 0; d < 64; ++d) { s1 += lp[d] * lp[64 + d]; s2 += lp[128 + d] * lp[192 + d]; }
    float li = 0.8f - 0.6f * expf(-0.3f * (float)l);
    p.lam[l * 2] = expf(s1) - expf(s2) + li; p.lam[l * 2 + 1] = li;
  }
}

DI void phase_pr0(const Params& p, char* smem, int bid, int nb) {
  if (bid == 0) misc_item(p);
  const int total = N_CONV_ITEMS + 192;
  for (int it = bid; it < total; it += nb) {
    if (it < 192) ada_item(p, it, smem);
    else conv_item(p, 0, it - 192, smem);
  }
}

DI void phase_pr1(const Params& p, int bid, int nb) {
  const int lane = tidx() & 63, wid = tidx() >> 6;
  for (int row = bid * 4 + wid; row < NTOK; row += nb * 4) {
    const float* xr = row < 4096 ? p.x_prompt + (size_t)row * 1024 : p.x_sample + (size_t)(row - 4096) * 1024;
    const float* md = p.mod + (0 * 3 + tok_cv(row)) * 6144;
    f32x4 vin[4], shv[4], scv[4];
#pragma unroll
    for (int it = 0; it < 4; ++it) { vin[it] = *(const GAS f32x4*)(xr + it * 256 + lane * 4);
      shv[it] = *(const GAS f32x4*)(md + it * 256 + lane * 4); scv[it] = *(const GAS f32x4*)(md + 1024 + it * 256 + lane * 4); }
#pragma unroll
    for (int it = 0; it < 4; ++it) {
      int col = it * 256 + lane * 4;
      float4 v; v.x = vin[it][0]; v.y = vin[it][1]; v.z = vin[it][2]; v.w = vin[it][3];
      float4 sh, sc; sh.x = shv[it][0]; sh.y = shv[it][1]; sh.z = shv[it][2]; sh.w = shv[it][3]; sc.x = scv[it][0]; sc.y = scv[it][1]; sc.z = scv[it][2]; sc.w = scv[it][3];
      uint2 o; o.x = pack2(v.x * (1.f + sc.x) + sh.x, v.y * (1.f + sc.y) + sh.y); o.y = pack2(v.z * (1.f + sc.z) + sh.z, v.w * (1.f + sc.w) + sh.w);
      *reinterpret_cast<uint2*>(p.h + (size_t)row * 1024 + col) = o;
    }
  }
}

DI void rot(float& a, float& b, float c, float s) { float na = a * c - b * s; b = b * c + a * s; a = na; }

DI void epi_p1(const Params& p, int l, f32x4 (&acc)[8][4], int m0, int nt) {
  const int lane = rtid() & 63, wid = rtid() >> 6, wm = wid >> 2, wn = wid & 3;
  const int lq = lane >> 4, lc = lane & 15;
  const int rbase = m0 + wm * 128;
  if (nt == 18) {
    if (wn == 0) {
#pragma unroll
      for (int mi = 0; mi < 8; ++mi)
#pragma unroll
        for (int j = 0; j < 4; ++j) { int tok = rbase + mi * 16 + lq * 4 + j; p.r[tok * 32 + lc] = acc[mi][0][j]; p.r[tok * 32 + 16 + lc] = acc[mi][1][j]; }
    }
    return;
  }
  const int cb = nt * 256 + wn * 64;
  if (cb >= 4096) {
    const int head = (cb - 4096) >> 7, dvb = (cb - 4096) & 127;
#pragma unroll
    for (int mi = 0; mi < 8; ++mi) {
      const int tok0 = rbase + mi * 16 + lq * 4;
#pragma unroll
      for (int ni = 0; ni < 4; ++ni) {
        const int dv = dvb + ni * 16 + lc;
        uint2 o; o.x = pack2(acc[mi][ni][0], acc[mi][ni][1]); o.y = pack2(acc[mi][ni][2], acc[mi][ni][3]);
        if (tok0 < 4096) {
          int b = tok0 >> 8, t = tok0 & 255;
          *reinterpret_cast<uint2*>(p.VcT_p + ((size_t)(b * 4 + head) * 128 + dv) * 256 + t) = o;
          float* ov = p.out + OUT_DV + ((size_t)((b * 2 + l) * 4 + head) * 256 + t) * 128 + dv;
#pragma unroll
          for (int j = 0; j < 4; ++j) ov[j * 128] = acc[mi][ni][j];
        } else {
          int bs = (tok0 - 4096) >> 12, t = (tok0 - 4096) & 4095;
          *reinterpret_cast<uint2*>(p.VcT_s + ((size_t)(bs * 4 + head) * 128 + dv) * 4352 + 256 + t) = o;
        }
      }
    }
    return;
  }
  const bool rope = (cb < 512) || (cb >= 3072);
  const float scale = ((cb >= 256 && cb < 512) || (cb >= 1536 && cb < 1792)) ? 0.125f : (cb >= 3072 && cb < 3584) ? 0.125f * LOG2E_F : 1.f;
  const bool dorope = rope && (m0 >= 4096);
#pragma unroll
  for (int mi = 0; mi < 8; ++mi) {
    float2 ra = make_float2(1.f, 0.f), rb4[4];
#pragma unroll
    for (int j = 0; j < 4; ++j) rb4[j] = make_float2(1.f, 0.f);
    if (dorope) {
      const int t0 = (rbase + mi * 16 + lq * 4 - 4096) & 4095;
      ra = *reinterpret_cast<const float2*>(p.rope + ((t0 >> 6) * 16 + lc) * 2);
#pragma unroll
      for (int j = 0; j < 4; ++j) rb4[j] = *reinterpret_cast<const float2*>(p.rope + (((t0 & 63) + j) * 16 + lc) * 2);
    }
#pragma unroll
    for (int j = 0; j < 4; ++j) {
      const int tok = rbase + mi * 16 + lq * 4 + j;
      float v0 = acc[mi][0][j] * scale, v1 = acc[mi][1][j] * scale, v2 = acc[mi][2][j] * scale, v3 = acc[mi][3][j] * scale;
      if (dorope) { rot(v0, v1, ra.x, ra.y); rot(v2, v3, rb4[j].x, rb4[j].y); }
      if (cb < 3584) {
        u16* d = p.proj + (size_t)tok * PLD + cb + lc;
        d[0] = f2bf(v0); d[16] = f2bf(v1); d[32] = f2bf(v2); d[48] = f2bf(v3);
      } else {
        const int g = (cb - 3584) >> 6;
        if (tok < 4096) {
          int b = tok >> 8, t = tok & 255;
          u16* d = p.Kc_p + ((size_t)(b * 8 + g) * 256 + t) * 64 + lc;
          d[0] = f2bf(v0); d[16] = f2bf(v1); d[32] = f2bf(v2); d[48] = f2bf(v3);
          float* o = p.out + OUT_DK + ((size_t)((b * 2 + l) * 8 + g) * 256 + t) * 64 + lc;
          o[0] = v0; o[16] = v1; o[32] = v2; o[48] = v3;
        } else {
          int bs = (tok - 4096) >> 12, t = (tok - 4096) & 4095;
          u16* d = p.Kc_s + ((size_t)(bs * 8 + g) * 4352 + 256 + t) * 64 + lc;
          d[0] = f2bf(v0); d[16] = f2bf(v1); d[32] = f2bf(v2); d[48] = f2bf(v3);
        }
      }
    }
  }
}

DI void ctx_item(const Params& p, int l, int it) {
  const int tid = tidx();
  if (it < 64) {
#pragma unroll
    for (int e0 = 0; e0 < 4096; e0 += 2048) {
      float v[8];
#pragma unroll
      for (int k = 0; k < 8; ++k) { const int idx = it * 4096 + e0 + k * 256 + tid;
        const int d = idx & 63, pos = (idx >> 6) & 255, g = (idx >> 14) & 7, b = idx >> 17;
        v[k] = ((const GAS float*)p.cache_k)[((size_t)((b * 2 + l) * 8 + g) * 256 + pos) * 64 + d]; }
#pragma unroll
      for (int k = 0; k < 8; ++k) { const int idx = it * 4096 + e0 + k * 256 + tid;
        const int d = idx & 63, pos = (idx >> 6) & 255, g = (idx >> 14) & 7, b = idx >> 17;
        p.Kc_s[((size_t)(b * 8 + g) * 4352 + pos) * 64 + d] = f2bf(v[k]); }
    }
  } else {
    it -= 64;
#pragma unroll
    for (int e0 = 0; e0 < 4096; e0 += 2048) {
      float v[8];
#pragma unroll
      for (int k = 0; k < 8; ++k) { const int idx = it * 4096 + e0 + k * 256 + tid;
        const int dv = idx & 127, pos = (idx >> 7) & 255, hd = (idx >> 15) & 3, b = idx >> 17;
        v[k] = ((const GAS float*)p.cache_v)[((size_t)((b * 2 + l) * 4 + hd) * 256 + pos) * 128 + dv]; }
#pragma unroll
      for (int k = 0; k < 8; ++k) { const int idx = it * 4096 + e0 + k * 256 + tid;
        const int dv = idx & 127, pos = (idx >> 7) & 255, hd = (idx >> 15) & 3, b = idx >> 17;
        p.VcT_s[((size_t)(b * 4 + hd) * 128 + dv) * 4352 + pos] = f2bf(v[k]); }
    }
  }
}

DI void phase_p1(const Params& p, int l, char* smem, int bid, int nb, int vbid, int vnb) {
  for (int it = vbid; it < 128; it += vnb) ctx_item(p, l, it);
  const int ntiles = 48 * 19;
  bool pre = false;
  for (int k = 0;; ++k) {
    const int it = xcd_tile(k, bid, nb);
    if (k * nb >= ntiles) break;
    if (it >= ntiles) continue;
    int mt, nt; tile_mn(it, 48, 19, mt, nt);
    const int it2 = xcd_tile(k + 1, bid, nb);
    const bool has_next = ((k + 1) * nb < ntiles) && (it2 < ntiles);
    int mt2 = 0, nt2 = 0; if (has_next) tile_mn(it2, 48, 19, mt2, nt2);
    const GemmNext nx{p.h, 1024, p.WinT, 1024, nt2 < 18 ? nt2 * 256 : 7680, 64, 4, mt2 * 256};
    f32x4 acc[8][4]; zero_acc<8>(acc);
    if (pre) { if (has_next) gemm_main<8, false, 4, true, true>(acc, p.h, 1024, mt * 256, NTOK - 1, p.WinT, 1024, nt < 18 ? nt * 256 : 7680, 1024, smem, 64, nx);
               else gemm_main<8, false, 4, true, false>(acc, p.h, 1024, mt * 256, NTOK - 1, p.WinT, 1024, nt < 18 ? nt * 256 : 7680, 1024, smem); }
    else     { if (has_next) gemm_main<8, false, 4, false, true>(acc, p.h, 1024, mt * 256, NTOK - 1, p.WinT, 1024, nt < 18 ? nt * 256 : 7680, 1024, smem, 64, nx);
               else gemm_main<8, false, 4, false, false>(acc, p.h, 1024, mt * 256, NTOK - 1, p.WinT, 1024, nt < 18 ? nt * 256 : 7680, 1024, smem); }
    pre = has_next;
    epi_p1(p, l, acc, mt * 256, nt);
  }
}

struct ChunkItem { int mixer, seq, chunk, h, tok0, sample, bidx; };
DI ChunkItem chunk_item(int it) {
  ChunkItem c; c.mixer = it / 768; int i = it % 768;
  if (i < 512) { c.sample = 1; int s = i >> 6; c.seq = 64 + s; c.chunk = i & 63; c.bidx = s >> 2; c.h = s & 3; c.tok0 = 4096 + c.bidx * 4096 + c.chunk * 64; }
  else { int j = i - 512; c.sample = 0; int s = j >> 2; c.seq = s; c.chunk = j & 3; c.bidx = s >> 2; c.h = s & 3; c.tok0 = c.bidx * 256 + c.chunk * 64; }
  return c;
}
DI size_t scan_off(const ChunkItem& c, int dir) {
  return (size_t)c.mixer * SCAN_MIX_ELEMS + (c.sample ? SCAN_SAMPLE_OFF + ((size_t)((c.seq - 64) * 2 + dir) * 64 + c.chunk) * 8192
                                                       : ((size_t)(c.seq * 2 + dir) * 4 + c.chunk) * 8192);
}
DI int dec_off(const ChunkItem& c, int dir) {
  return c.mixer * DEC_MIX + (c.sample ? DEC_SAMPLE_OFF + (((c.seq - 64) * 2 + dir) * 64 + c.chunk) * 64 : ((c.seq * 2 + dir) * 4 + c.chunk) * 64);
}

DI void compute_cum(const Params& p, int l, const ChunkItem& c, int e, float* sCum, float* sTot, float* sR) {
  const int tid = tidx();
  if (c.mixer == 0) {
    const float lg = logsigf_(p.ret_decay[(l * 2 + e) * 4 + c.h]);
    for (int idx = tid; idx < 4096; idx += 256) { int i = idx >> 6; sCum[idx] = (e == 0 ? (float)(i + 1) : (float)(64 - i)) * lg; }
    __syncthreads();
    return;
  }
  const int dk = tid & 63, qq = tid >> 6;
  const float* wa2 = p.gla_wa2 + ((size_t)(l * 2 + e) * 16) * 256 + c.h * 64 + dk;
  float w[16];
#pragma unroll
  for (int r = 0; r < 16; ++r) w[r] = wa2[r * 256];
  const float ba = p.gla_ba[(l * 2 + e) * 256 + c.h * 64 + dk];
  *reinterpret_cast<f32x4*>(sR + tid * 4) = *(const GAS f32x4*)(p.r + (size_t)(c.tok0 + (tid >> 2)) * 32 + e * 16 + (tid & 3) * 4);
  __syncthreads();
  float run = 0.f;
#pragma unroll 4
  for (int s = 0; s < 16; ++s) {
    const int i = e == 0 ? qq * 16 + s : qq * 16 + 15 - s;
    const float4* rp = reinterpret_cast<const float4*>(sR + i * 16);
    float4 r0 = rp[0], r1 = rp[1], r2 = rp[2], r3 = rp[3];
    float z = ba + r0.x * w[0] + r0.y * w[1] + r0.z * w[2] + r0.w * w[3] + r1.x * w[4] + r1.y * w[5] + r1.z * w[6] + r1.w * w[7]
                 + r2.x * w[8] + r2.y * w[9] + r2.z * w[10] + r2.w * w[11] + r3.x * w[12] + r3.y * w[13] + r3.z * w[14] + r3.w * w[15];
    run += logsigf_(z) * 0.0625f;
    sCum[i * 64 + dk] = run;
  }
  sTot[qq * 64 + dk] = run;
  __syncthreads();
  float off = 0.f;
  for (int g = 0; g < 4; ++g) if (e == 0 ? g < qq : g > qq) off += sTot[g * 64 + dk];
#pragma unroll 4
  for (int s = 0; s < 16; ++s) sCum[(qq * 16 + s) * 64 + dk] += off;
  __syncthreads();
}

DI void load_vt(const Params& p, const ChunkItem& c, u16* sVT) {
  const int tid = tidx();
  const int vcol = (c.mixer == 0 ? 512 : 2048) + c.h * 128;
#pragma unroll
  for (int it = 0; it < 4; ++it) {
    int ch = tid + 256 * it; int i = ch & 63, dvc = ch >> 6;
    uint4 v = *reinterpret_cast<const uint4*>(p.proj + (size_t)(c.tok0 + i) * PLD + vcol + dvc * 8);
    const u16* e = reinterpret_cast<const u16*>(&v);
#pragma unroll
    for (int k = 0; k < 8; ++k) sVT[(dvc * 8 + k) * 72 + i] = e[k];
  }
}

DI void p2a_item(const Params& p, int l, int it, char* smem) {
  const ChunkItem c = chunk_item(it);
  float* sCum = reinterpret_cast<float*>(smem);
  float* sTot = reinterpret_cast<float*>(smem + 16384);
  u16* sVT = reinterpret_cast<u16*>(smem + 17408);
  u16* sKT = reinterpret_cast<u16*>(smem + 35840);
  const int tid = tidx(), lane = tid & 63, wid = tid >> 6, lr16 = lane & 15, q = lane >> 4;
  const int kcol = (c.mixer == 0 ? 256 : 1792) + c.h * 64;
  u32x4 kreg0, kreg1;
  {
    gcu16p pg = (gcu16p)p.proj;
    kreg0 = *(gcu4p)(pg + (size_t)(c.tok0 + (tid & 63)) * PLD + kcol + (tid >> 6) * 8);
    kreg1 = *(gcu4p)(pg + (size_t)(c.tok0 + (tid & 63)) * PLD + kcol + ((tid >> 6) + 4) * 8);
  }
  load_vt(p, c, sVT);
  for (int e = 0; e < 2; ++e) {
    compute_cum(p, l, c, e, sCum, sTot, reinterpret_cast<float*>(smem + 45056));
    const int iref = e == 0 ? 63 : 0;
#define P2A_KT(kr_, dkc_) do { const int i = tid & 63; \
      _Pragma("unroll") for (int k = 0; k < 4; ++k) { \
        const int dk = (dkc_) * 8 + 2 * k; \
        sKT[dk * 72 + i] = f2bf(__uint_as_float(kr_[k] << 16) * __expf(sCum[iref * 64 + dk] - sCum[i * 64 + dk])); \
        sKT[(dk + 1) * 72 + i] = f2bf(__uint_as_float(kr_[k] & 0xffff0000u) * __expf(sCum[iref * 64 + dk + 1] - sCum[i * 64 + dk + 1])); } } while (0)
    P2A_KT(kreg0, (tid >> 6)); P2A_KT(kreg1, (tid >> 6) + 4);
    if (tid < 64) p.dec[dec_off(c, e) + tid] = __expf(sCum[iref * 64 + tid]);
    __syncthreads();
    f32x4 acc[2][4];
#pragma unroll
    for (int mi = 0; mi < 2; ++mi)
#pragma unroll
      for (int ni = 0; ni < 4; ++ni) acc[mi][ni] = zero4();
#pragma unroll
    for (int ks = 0; ks < 2; ++ks) {
      bf16x8 af[2], bfr[4];
#pragma unroll
      for (int mi = 0; mi < 2; ++mi) af[mi] = *reinterpret_cast<const bf16x8*>(sVT + (wid * 32 + mi * 16 + lr16) * 72 + ks * 32 + q * 8);
#pragma unroll
      for (int ni = 0; ni < 4; ++ni) bfr[ni] = *reinterpret_cast<const bf16x8*>(sKT + (ni * 16 + lr16) * 72 + ks * 32 + q * 8);
#pragma unroll
      for (int mi = 0; mi < 2; ++mi)
#pragma unroll
        for (int ni = 0; ni < 4; ++ni) acc[mi][ni] = MFMA16(af[mi], bfr[ni], acc[mi][ni]);
    }
    u16* dst = p.scan + scan_off(c, e);
#pragma unroll
    for (int mi = 0; mi < 2; ++mi)
#pragma unroll
      for (int ni = 0; ni < 4; ++ni)
#pragma unroll
        for (int j = 0; j < 4; ++j) dst[(wid * 32 + mi * 16 + q * 4 + j) * 64 + ni * 16 + lr16] = f2bf(acc[mi][ni][j]);
    __syncthreads();
  }
}

template <int NCH>
DI void scan_unit(const Params& p, int l, int mixer, int seq, int dir, int eb, int sample) {
  const int el = eb * 256 + tidx(); const int dv = el >> 6, dk = el & 63;
  const int bidx = sample ? (seq - 64) >> 2 : seq >> 2; const int h = seq & 3;
  u16* buf = p.scan + (size_t)mixer * SCAN_MIX_ELEMS + (sample ? SCAN_SAMPLE_OFF + (size_t)((seq - 64) * 2 + dir) * 64 * 8192 : (size_t)(seq * 2 + dir) * 4 * 8192) + el;
  const float* dc = p.dec + mixer * DEC_MIX + (sample ? DEC_SAMPLE_OFF + ((seq - 64) * 2 + dir) * 64 * 64 : (seq * 2 + dir) * 4 * 64) + dk;
  float s = 0.f;
  if (sample) { const float* st = mixer == 0 ? p.state_ret : p.state_gla; s = st[((size_t)((bidx * 2 + l) * 2 + dir) * 4 + h) * 8192 + dk * 128 + dv]; }
  constexpr int BT = NCH < 16 ? NCH : 16;
  for (int n0 = 0; n0 < NCH; n0 += BT) {
    float d[BT], g[BT];
#pragma unroll
    for (int k = 0; k < BT; ++k) { int n = dir == 0 ? n0 + k : NCH - 1 - n0 - k; d[k] = bf2f(buf[(size_t)n * 8192]); g[k] = dc[n * 64]; }
#pragma unroll
    for (int k = 0; k < BT; ++k) { int n = dir == 0 ? n0 + k : NCH - 1 - n0 - k; buf[(size_t)n * 8192] = f2bf(s); s = g[k] * s + d[k]; }
  }
  if (!sample) { float* o = p.out + (mixer == 0 ? OUT_SRET : OUT_SGLA); o[((size_t)((bidx * 2 + l) * 2 + dir) * 4 + h) * 8192 + dk * 128 + dv] = s; }
}
DI void scan_quad(const Params& p, int l, int mixer, int seq, int dir, int eb0) {
  const int tid = tidx(); const int dk = tid & 63;
  const int bidx = seq >> 2, h = seq & 3;
  u16* buf = p.scan + (size_t)mixer * SCAN_MIX_ELEMS + (size_t)(seq * 2 + dir) * 4 * 8192 + eb0 * 256 + tid;
  const float* dc = p.dec + mixer * DEC_MIX + (seq * 2 + dir) * 4 * 64 + dk;
  float d[4][4], g[4];
#pragma unroll
  for (int k = 0; k < 4; ++k) { const int n = dir == 0 ? k : 3 - k; g[k] = dc[n * 64];
#pragma unroll
    for (int q = 0; q < 4; ++q) d[q][k] = bf2f(buf[(size_t)n * 8192 + q * 256]); }
  float s[4] = {0.f, 0.f, 0.f, 0.f};
#pragma unroll
  for (int k = 0; k < 4; ++k) { const int n = dir == 0 ? k : 3 - k;
#pragma unroll
    for (int q = 0; q < 4; ++q) { buf[(size_t)n * 8192 + q * 256] = f2bf(s[q]); s[q] = g[k] * s[q] + d[q][k]; } }
  float* o = p.out + (mixer == 0 ? OUT_SRET : OUT_SGLA) + ((size_t)((bidx * 2 + l) * 2 + dir) * 4 + h) * 8192;
#pragma unroll
  for (int q = 0; q < 4; ++q) { const int el = (eb0 + q) * 256 + tid; o[(el & 63) * 128 + (el >> 6)] = s[q]; }
}
DI void phase_p2b(const Params& p, int l, int bid, int nb) {
  for (int u = bid; u < 1024 + 2048; u += nb) {
    if (u < 1024) { int mixer = u >> 9, rem = u & 511; scan_unit<64>(p, l, mixer, 64 + (rem >> 6), (rem >> 5) & 1, rem & 31, 1); }
    else { int v = u - 1024; int mixer = v >> 10, rem = v & 1023; scan_quad(p, l, mixer, rem >> 4, (rem >> 3) & 1, (rem & 7) * 4); }
  }
}

DI void p2c_mix_item(const Params& p, int l, int it, char* smem) {
  const ChunkItem c = chunk_item(it);
  u16* sQf = reinterpret_cast<u16*>(smem);
  u16* sQb = reinterpret_cast<u16*>(smem + 9216);
  u16* sKf = reinterpret_cast<u16*>(smem + 18432);
  u16* sKb = reinterpret_cast<u16*>(smem + 27648);
  float* sCum = reinterpret_cast<float*>(smem + 36864);
  u16* sVT = reinterpret_cast<u16*>(smem + 36864);
  u16* sP = reinterpret_cast<u16*>(smem + 55296);
  float* sTot = reinterpret_cast<float*>(smem + 64512);
  const int tid = tidx(), lane = tid & 63, wid = tid >> 6, lr16 = lane & 15, q = lane >> 4;
  const int qcol = (c.mixer == 0 ? 0 : 1536) + c.h * 64, kcol = (c.mixer == 0 ? 256 : 1792) + c.h * 64;
  u32x4 qv0, qv1, kv0, kv1, vv0, vv1, vv2, vv3;
  {
    gcu16p pg = (gcu16p)p.proj;
    const int i0 = tid >> 3, dkc = tid & 7;
    qv0 = *(gcu4p)(pg + (size_t)(c.tok0 + i0) * PLD + dkc * 8 + qcol); qv1 = *(gcu4p)(pg + (size_t)(c.tok0 + i0 + 32) * PLD + dkc * 8 + qcol);
    kv0 = *(gcu4p)(pg + (size_t)(c.tok0 + i0) * PLD + dkc * 8 + kcol); kv1 = *(gcu4p)(pg + (size_t)(c.tok0 + i0 + 32) * PLD + dkc * 8 + kcol);
    const int vcol = (c.mixer == 0 ? 512 : 2048) + c.h * 128; const int vi = tid & 63, dvc = tid >> 6;
    vv0 = *(gcu4p)(pg + (size_t)(c.tok0 + vi) * PLD + vcol + dvc * 8); vv1 = *(gcu4p)(pg + (size_t)(c.tok0 + vi) * PLD + vcol + (dvc + 4) * 8);
    vv2 = *(gcu4p)(pg + (size_t)(c.tok0 + vi) * PLD + vcol + (dvc + 8) * 8); vv3 = *(gcu4p)(pg + (size_t)(c.tok0 + vi) * PLD + vcol + (dvc + 12) * 8);
  }
  bf16x8 stf[2][8], stb[2][8];
  {
    typedef const GAS bf16x8* gfrag;
    gcu16p STf = (gcu16p)p.scan + scan_off(c, 0);
    gcu16p STb = (gcu16p)p.scan + scan_off(c, 1);
    const int lr16_ = (tid & 63) & 15, q_ = (tid & 63) >> 4;
#pragma unroll
    for (int ks = 0; ks < 2; ++ks)
#pragma unroll
      for (int nd = 0; nd < 8; ++nd) {
        stf[ks][nd] = *(gfrag)(STf + (nd * 16 + lr16_) * 64 + ks * 32 + q_ * 8);
        stb[ks][nd] = *(gfrag)(STb + (nd * 16 + lr16_) * 64 + ks * 32 + q_ * 8);
      }
  }
#define MIX_BUILD(qv_, kv_, i_) do { const int dkc = tid & 7; \
      float cm[8]; _Pragma("unroll") for (int k = 0; k < 8; ++k) cm[k] = sCum[(i_) * 64 + dkc * 8 + k]; \
      u32x4 qo, ko; \
      _Pragma("unroll") for (int k = 0; k < 4; ++k) { \
        const float q0 = __uint_as_float(qv_[k] << 16), q1 = __uint_as_float(qv_[k] & 0xffff0000u); \
        const float k0 = __uint_as_float(kv_[k] << 16), k1 = __uint_as_float(kv_[k] & 0xffff0000u); \
        qo[k] = pack2(q0 * __expf(cm[2 * k]), q1 * __expf(cm[2 * k + 1])); \
        ko[k] = pack2(k0 * __expf(-cm[2 * k]), k1 * __expf(-cm[2 * k + 1])); } \
      *reinterpret_cast<u32x4*>(sQ + (i_) * 72 + dkc * 8) = qo; \
      *reinterpret_cast<u32x4*>(sK + (i_) * 72 + dkc * 8) = ko; } while (0)
  for (int e = 0; e < 2; ++e) {
    compute_cum(p, l, c, e, sCum, sTot, reinterpret_cast<float*>(smem + 55296));
    u16* sQ = e == 0 ? sQf : sQb; u16* sK = e == 0 ? sKf : sKb;
    MIX_BUILD(qv0, kv0, (tid >> 3));
    MIX_BUILD(qv1, kv1, (tid >> 3) + 32);
    __syncthreads();
  }
#define MIX_VT(vv_, dvc_) do { const int vi = tid & 63; \
      _Pragma("unroll") for (int k = 0; k < 4; ++k) { sVT[((dvc_) * 8 + 2 * k) * 72 + vi] = (u16)(vv_[k] & 0xffffu); sVT[((dvc_) * 8 + 2 * k + 1) * 72 + vi] = (u16)(vv_[k] >> 16); } } while (0)
  MIX_VT(vv0, (tid >> 6)); MIX_VT(vv1, (tid >> 6) + 4); MIX_VT(vv2, (tid >> 6) + 8); MIX_VT(vv3, (tid >> 6) + 12);
  const int irow = wid * 16;
  bf16x8 aQf[2], aQb[2];
#pragma unroll
  for (int ks = 0; ks < 2; ++ks) { aQf[ks] = *reinterpret_cast<const bf16x8*>(sQf + (irow + lr16) * 72 + ks * 32 + q * 8); aQb[ks] = *reinterpret_cast<const bf16x8*>(sQb + (irow + lr16) * 72 + ks * 32 + q * 8); }
#pragma unroll
  for (int nj = 0; nj < 4; ++nj) {
    f32x4 sf = zero4(), sb = zero4();
#pragma unroll
    for (int ks = 0; ks < 2; ++ks) {
      bf16x8 kf = *reinterpret_cast<const bf16x8*>(sKf + (nj * 16 + lr16) * 72 + ks * 32 + q * 8);
      bf16x8 kb = *reinterpret_cast<const bf16x8*>(sKb + (nj * 16 + lr16) * 72 + ks * 32 + q * 8);
      sf = MFMA16(aQf[ks], kf, sf); sb = MFMA16(aQb[ks], kb, sb);
    }
    const int jj = nj * 16 + lr16;
#pragma unroll
    for (int j = 0; j < 4; ++j) { int i = irow + q * 4 + j; float v = jj < i ? sf[j] : (jj > i ? sb[j] : sf[j] + sb[j]); sP[i * 72 + jj] = f2bf(v); }
  }
  __syncthreads();
  f32x4 o[8];
#pragma unroll
  for (int nd = 0; nd < 8; ++nd) o[nd] = zero4();
#pragma unroll
  for (int ks = 0; ks < 2; ++ks) {
    bf16x8 aP = *reinterpret_cast<const bf16x8*>(sP + (irow + lr16) * 72 + ks * 32 + q * 8);
#pragma unroll
    for (int nd = 0; nd < 8; ++nd) {
      bf16x8 vb = *reinterpret_cast<const bf16x8*>(sVT + (nd * 16 + lr16) * 72 + ks * 32 + q * 8);
      o[nd] = MFMA16(aP, vb, o[nd]);
      o[nd] = MFMA16(aQf[ks], stf[ks][nd], o[nd]);
      o[nd] = MFMA16(aQb[ks], stb[ks][nd], o[nd]);
    }
  }
  const int gcol = (c.mixer == 0 ? 1024 : 2560) + c.h * 128, ycol = (c.mixer == 0 ? 512 : 2048) + c.h * 128;
  float gng[8];
#pragma unroll
  for (int nd = 0; nd < 8; ++nd) gng[nd] = c.mixer == 1 ? p.gla_norm_g[l * 128 + nd * 16 + lr16] : 1.f;
#pragma unroll
  for (int j = 0; j < 4; ++j) {
    float s = 0.f, ss = 0.f;
#pragma unroll
    for (int nd = 0; nd < 8; ++nd) { float v = o[nd][j]; s += v; ss += v * v; }
#pragma unroll
    for (int m = 1; m < 16; m <<= 1) { s += __shfl_xor(s, m); ss += __shfl_xor(ss, m); }
    const int tok = c.tok0 + irow + q * 4 + j;
    float mean, rstd;
    if (c.mixer == 0) { mean = s * (1.f / 128.f); float var = ss * (1.f / 128.f) - mean * mean; rstd = rsqrtf(fmaxf(var, 0.f) + EPS_F); }
    else { mean = 0.f; rstd = rsqrtf(ss * (1.f / 128.f) + EPS_F); }
    u16 gr[8];
#pragma unroll
    for (int nd = 0; nd < 8; ++nd) gr[nd] = ((const GAS u16*)p.proj)[(size_t)tok * PLD + gcol + nd * 16 + lr16];
#pragma unroll
    for (int nd = 0; nd < 8; ++nd) {
      const int dv = nd * 16 + lr16;
      float g = siluf_(bf2f(gr[nd]));
      float y = (o[nd][j] - mean) * rstd;
      if (c.mixer == 1) y *= gng[nd];
      p.proj[(size_t)tok * PLD + ycol + dv] = f2bf(y * g);
    }
  }
  __syncthreads();
}

DI void attn_item(const Params& p, int l, int it, char* smem) {
  int b, head, qb, Tk, tokbase;
  const u16 *Kc, *VcT;
  if (it < 256) { b = it >> 7; head = (it >> 5) & 3; qb = it & 31; Tk = 4352; tokbase = 4096 + b * 4096; Kc = p.Kc_s; VcT = p.VcT_s; }
  else { int j = it - 256; b = j >> 3; head = (j >> 1) & 3; qb = j & 1; Tk = 256; tokbase = b * 256; Kc = p.Kc_p; VcT = p.VcT_p; }
  const int tid = rtid(), lane = tid & 63, wid = tid >> 6, r = lane & 31, hh = lane >> 5;
  const int sub = wid >> 2, qrow0 = qb * 128 + 32 * (wid & 3);
  gcu16p K0 = (gcu16p)Kc + (size_t)(b * 8 + head * 2) * Tk * 64;
  gcu16p K1 = K0 + (size_t)Tk * 64;
  gcu16p VT = (gcu16p)VcT + (size_t)(b * 4 + head) * 128 * Tk;
  bf16x8 qf[4];
  {
    const u16* qp = p.proj + (size_t)(tokbase + qrow0 + r) * PLD + 3072 + (head * 2 + sub) * 64 + hh * 8;
#pragma unroll
    for (int ks = 0; ks < 4; ++ks) qf[ks] = *reinterpret_cast<const bf16x8*>(qp + ks * 16);
  }
  const int krow = tid >> 3, kch = tid & 7;
  const int ksw = (kch ^ ((krow >> 1) & 7)) << 4;
  u32x4 ak0, ak1, av0, av1, bk0, bk1, bv0, bv1;
#define ATT_GLOAD(P, t_) do { const int key0 = (t_) * 64; \
    P##k0 = *(gcu4p)(K0 + (size_t)(key0 + krow) * 64 + kch * 8); \
    P##k1 = *(gcu4p)(K1 + (size_t)(key0 + krow) * 64 + kch * 8); \
    P##v0 = *(gcu4p)(VT + (size_t)(krow) * Tk + key0 + kch * 8); \
    P##v1 = *(gcu4p)(VT + (size_t)(krow + 64) * Tk + key0 + kch * 8); } while (0)
#define ATT_VST(rv_, row_) do { const int f = ((row_) >> 1) & 15; \
      char* rowp = sbw + 16384 + (row_) * 128; \
      uint2 lo, hi; lo.x = rv_.x; lo.y = rv_.y; hi.x = rv_.z; hi.y = rv_.w; \
      *reinterpret_cast<uint2*>(rowp + (((2 * kch) ^ f) << 3)) = lo; \
      *reinterpret_cast<uint2*>(rowp + (((2 * kch + 1) ^ f) << 3)) = hi; } while (0)
#define ATT_SSTORE(P, sbw_) do { char* sbw = (sbw_); \
    *reinterpret_cast<u32x4*>(sbw + krow * 128 + ksw) = P##k0; \
    *reinterpret_cast<u32x4*>(sbw + 8192 + krow * 128 + ksw) = P##k1; \
    ATT_VST(P##v0, krow); ATT_VST(P##v1, krow + 64); } while (0)
  f32x16 oacc[4];
#pragma unroll
  for (int d = 0; d < 4; ++d)
#pragma unroll
    for (int i = 0; i < 16; ++i) oacc[d][i] = 0.f;
  float m_run = -1e30f, l_run = 0.f;
  const int nt = Tk >> 6;
  const int kswz = (r >> 1) & 7;
  const int vf = (r >> 1) & 15;
#define ATT_TILE(sb_) do { \
    const char* sK = (sb_) + sub * 8192; \
    const char* sV = (sb_) + 16384; \
    f32x16 st[2]; \
    _Pragma("unroll") for (int kb = 0; kb < 2; ++kb) { \
      _Pragma("unroll") for (int i = 0; i < 16; ++i) st[kb][i] = 0.f; \
      _Pragma("unroll") for (int ks = 0; ks < 4; ++ks) { \
        bf16x8 kf = *reinterpret_cast<const bf16x8*>(sK + (kb * 32 + r) * 128 + (((2 * ks + hh) ^ kswz) << 4)); \
        __builtin_amdgcn_s_setprio(1); \
        st[kb] = MFMA32(kf, qf[ks], st[kb]); \
        __builtin_amdgcn_s_setprio(0); } } \
    __builtin_amdgcn_sched_barrier(0); \
    float mx = st[0][0]; \
    _Pragma("unroll") for (int i = 1; i < 16; ++i) mx = fmaxf(mx, st[0][i]); \
    _Pragma("unroll") for (int i = 0; i < 16; ++i) mx = fmaxf(mx, st[1][i]); \
    mx = fmaxf(mx, __shfl_xor(mx, 32)); \
      \
    float alpha = 1.f; \
    if (!__all((mx - m_run) <= 8.f)) { \
      const float m_new = fmaxf(m_run, mx); \
      alpha = __builtin_amdgcn_exp2f(m_run - m_new); \
      m_run = m_new; \
      _Pragma("unroll") for (int d = 0; d < 4; ++d) \
        _Pragma("unroll") for (int i = 0; i < 16; ++i) oacc[d][i] *= alpha; \
    } \
    float ps = 0.f; \
    _Pragma("unroll") for (int kb = 0; kb < 2; ++kb) \
      _Pragma("unroll") for (int i = 0; i < 16; ++i) { float e = __builtin_amdgcn_exp2f(st[kb][i] - m_run); st[kb][i] = e; ps += e; } \
    l_run = l_run * alpha + ps; \
    __builtin_amdgcn_sched_barrier(0); \
    _Pragma("unroll") for (int kb = 0; kb < 2; ++kb) \
      _Pragma("unroll") for (int s2 = 0; s2 < 2; ++s2) { \
        union { bf16x8 v; unsigned u[4]; } pf; \
        pf.u[0] = pack2(st[kb][8 * s2 + 0], st[kb][8 * s2 + 1]); pf.u[1] = pack2(st[kb][8 * s2 + 2], st[kb][8 * s2 + 3]); \
        pf.u[2] = pack2(st[kb][8 * s2 + 4], st[kb][8 * s2 + 5]); pf.u[3] = pack2(st[kb][8 * s2 + 6], st[kb][8 * s2 + 7]); \
        const int u0 = 8 * kb + 4 * s2 + hh; \
        _Pragma("unroll") for (int d = 0; d < 4; ++d) { \
          const char* rowp = sV + (d * 32 + r) * 128; \
          union { bf16x8 v; uint2 h2[2]; } vfr; \
          vfr.h2[0] = *reinterpret_cast<const uint2*>(rowp + ((u0 ^ vf) << 3)); \
          vfr.h2[1] = *reinterpret_cast<const uint2*>(rowp + (((u0 + 2) ^ vf) << 3)); \
          __builtin_amdgcn_s_setprio(1); \
          oacc[d] = MFMA32(vfr.v, pf.v, oacc[d]); \
          __builtin_amdgcn_s_setprio(0); } \
        __builtin_amdgcn_sched_barrier(0); } } while (0)
#define ATT_BAR() asm volatile("s_waitcnt lgkmcnt(0)\n\ts_barrier" ::: "memory")
  ATT_GLOAD(a, 0);
  ATT_GLOAD(b, 1);
  ATT_SSTORE(a, smem);
  __syncthreads();
#pragma unroll 1
  for (int t = 0; t < nt; t += 2) {
    { int t2 = t + 2; t2 = t2 > nt - 1 ? nt - 1 : t2; ATT_GLOAD(a, t2); }
    ATT_TILE(smem);
    ATT_SSTORE(b, smem + 32768);
    ATT_BAR();
    { int t3 = t + 3; t3 = t3 > nt - 1 ? nt - 1 : t3; ATT_GLOAD(b, t3); }
    ATT_TILE(smem + 32768);
    ATT_SSTORE(a, smem);
    ATT_BAR();
  }
  __syncthreads();
  l_run += __shfl_xor(l_run, 32);
  const float inv = 1.f / l_run;
  float* sO = reinterpret_cast<float*>(smem);
  if (sub == 1) {
#pragma unroll
    for (int d = 0; d < 4; ++d)
#pragma unroll
      for (int i = 0; i < 16; ++i) { int dv = d * 32 + (i & 3) + 8 * (i >> 2) + 4 * hh; sO[((wid & 3) * 128 + dv) * 32 + r] = oacc[d][i] * inv; }
  }
  __syncthreads();
  if (sub == 0) {
    const float lam = p.lam[l * 2], li = p.lam[l * 2 + 1];
    float ss = 0.f;
#pragma unroll
    for (int d = 0; d < 4; ++d)
#pragma unroll
      for (int i = 0; i < 16; ++i) { int dv = d * 32 + (i & 3) + 8 * (i >> 2) + 4 * hh; float v = oacc[d][i] * inv - lam * sO[((wid & 3) * 128 + dv) * 32 + r]; oacc[d][i] = v; ss += v * v; }
    ss += __shfl_xor(ss, 32);
    const float sc = rsqrtf(ss * (1.f / 128.f) + EPS_F) * (1.f - li);
    u16* yp = p.proj + (size_t)(tokbase + qrow0 + r) * PLD + 3072 + head * 128;
    const float* gg = p.diff_subln_g + l * 128;
#pragma unroll
    for (int d = 0; d < 4; ++d)
#pragma unroll
      for (int g4 = 0; g4 < 4; ++g4) {
        const int dv = d * 32 + 8 * g4 + 4 * hh;
        uint2 o2; o2.x = pack2(oacc[d][4 * g4] * sc * gg[dv], oacc[d][4 * g4 + 1] * sc * gg[dv + 1]);
        o2.y = pack2(oacc[d][4 * g4 + 2] * sc * gg[dv + 2], oacc[d][4 * g4 + 3] * sc * gg[dv + 3]);
        *reinterpret_cast<uint2*>(yp + dv) = o2;
      }
  }
  __syncthreads();
}

DI void phase_p2a(const Params& p, int l, char* smem, int bid, int nb) { for (int it = bid; it < 1536; it += nb) p2a_item(p, l, it, smem); }
DI void phase_p2c(const Params& p, int l, char* smem_all, char* smem, int rbid, int rnb, int bid, int nb) {
  for (int it = rbid; it < 384; it += rnb) attn_item(p, l, it, smem_all);
  for (int it = bid; it < 1536; it += nb) p2c_mix_item(p, l, it, smem);
}

DI void phase_p3(const Params& p, int l, char* smem, int bid, int nb) {
  (void)l;
  u16* merged = p.scan;
  for (int k = 0;; ++k) {
    const int it = xcd_tile(k, bid, nb);
    if (k * nb >= 768) break;
    if (it >= 768) continue;
    int mt, nt; tile_mn(it, 48, 16, mt, nt);
    f32x4 sg[2][12]; zero_acc<2, 12>(sg);
    gemm_main<2, false, 12, false, true>(sg, p.h, 1024, mt * 256, NTOK - 1, p.WinT, 1024, 4608 + nt * 64, 1024, smem, 1024,
                                         GemmNext{p.proj + 512, PLD, p.WbT, 512, nt * 64, 64, 1, mt * 256});
    unsigned sgp[2][12][2];
#pragma unroll
    for (int a = 0; a < 2; ++a)
#pragma unroll
      for (int b = 0; b < 12; ++b) { sgp[a][b][0] = pack2(sigmoidf_(sg[a][b][0]), sigmoidf_(sg[a][b][1])); sgp[a][b][1] = pack2(sigmoidf_(sg[a][b][2]), sigmoidf_(sg[a][b][3])); __builtin_amdgcn_sched_barrier(0); }
    f32x4 tot[2][4]; zero_acc<2>(tot);
#pragma unroll
    for (int i = 0; i < 3; ++i) {
      f32x4 acc[2][4]; zero_acc<2>(acc);
      const int ycol = i == 0 ? 512 : (i == 1 ? 2048 : 3072);
      const int ycol2 = i == 0 ? 2048 : 3072;
      if (i < 2) gemm_main<2, false, 4, true, true>(acc, p.proj + ycol, PLD, mt * 256, NTOK - 1, p.WbT + (size_t)i * 1024 * 512, 512, nt * 64, 512, smem, 64,
                                                    GemmNext{p.proj + ycol2, PLD, p.WbT + (size_t)(i + 1) * 1024 * 512, 512, nt * 64, 64, 1, mt * 256});
      else gemm_main<2, false, 4, true, false>(acc, p.proj + ycol, PLD, mt * 256, NTOK - 1, p.WbT + (size_t)i * 1024 * 512, 512, nt * 64, 512, smem);
#pragma unroll
      for (int a = 0; a < 2; ++a)
#pragma unroll
        for (int b = 0; b < 4; ++b)
        {
          tot[a][b][0] += __uint_as_float(sgp[a][i * 4 + b][0] << 16) * acc[a][b][0];
          tot[a][b][1] += __uint_as_float(sgp[a][i * 4 + b][0] & 0xffff0000u) * acc[a][b][1];
          tot[a][b][2] += __uint_as_float(sgp[a][i * 4 + b][1] << 16) * acc[a][b][2];
          tot[a][b][3] += __uint_as_float(sgp[a][i * 4 + b][1] & 0xffff0000u) * acc[a][b][3];
        }
    }
    const int lane = rtid() & 63, wid = rtid() >> 6, lq = lane >> 4, lc = lane & 15;
#pragma unroll
    for (int a = 0; a < 2; ++a)
#pragma unroll
      for (int j = 0; j < 4; ++j) {
        const int tok = mt * 256 + wid * 32 + a * 16 + lq * 4 + j;
        u16* d = merged + (size_t)tok * 1024 + nt * 64 + lc;
        d[0] = f2bf(tot[a][0][j]); d[16] = f2bf(tot[a][1][j]); d[32] = f2bf(tot[a][2][j]); d[48] = f2bf(tot[a][3][j]);
      }
  }
}

#define PAN_WORD(c_, mt_) (3456 + ((c_) * 48 + (mt_)) * 64)
#define BAR_TOTAL_WORDS (3456 + 4 * 48 * 64)
DI void phase_res(const Params& p, int l, int which, char* smem, int bid, int nb) {
  const u16* A = which == 0 ? p.scan : p.proj; const int lda = which == 0 ? 1024 : 2816;
  const u16* B = which == 0 ? p.WoT : p.WdT; const int K = lda;
  const bool from_in = (l == 0 && which == 0);
  const bool has_next = (which == 0) || (l + 1 < 2);
  for (int it0 = bid; it0 < ((nb >> 3) * 8); it0 += nb) {
    const int per = 192 / 8, j = it0 >> 3;
    if (j >= per) {
      if (which == 1 && l == 0) {
        const int half = __builtin_amdgcn_readfirstlane((int)(threadIdx.x >> 8));
        const int vb = ((it0 & 7) + 8 * (j - per)) * 2 + half, vn = ((nb >> 3) - per) * 16;
        for (int ci = vb; ci < 1920; ci += vn) conv_item(p, 1, ci, smem + half * 65536);
      }
      continue;
    }
    const int it = (it0 & 7) * per + j;
    int mt, nt; tile_mn(it, 48, 4, mt, nt);
    f32x4 acc[8][4]; zero_acc<8>(acc);
    gemm_main<8, true>(acc, A, lda, mt * 256, NTOK - 1, B, K, nt * 256, K, smem);
    const int tid = rtid(), lane = tid & 63, wid = tid >> 6, wm = wid >> 2, wn = wid & 3, lq = lane >> 4, lc = lane & 15;
    const int row0 = mt * 256;
    const int cv = tok_cv(row0);
    const float* xt = from_in ? (row0 < 4096 ? p.x_prompt + (size_t)row0 * 1024 : p.x_sample + (size_t)(row0 - 4096) * 1024) : p.out + (size_t)row0 * 1024;
    const int cb = nt * 256 + wn * 64 + lq * 4;
    float* sRed = reinterpret_cast<float*>(smem);
    {
      const GAS f32x4* gm = (const GAS f32x4*)(p.mod + (l * 3 + cv) * 6144 + (which ? 5120 : 2048) + cb);
      f32x4 gv[4];
#pragma unroll
      for (int b = 0; b < 4; ++b) gv[b] = gm[b * 4];
#pragma unroll
      for (int a2 = 0; a2 < 4; ++a2) {
        int rloc = wm * 128 + a2 * 32 + lc;
        asm volatile("" : "+v"(rloc));
        f32x4 xv[2][4];
#pragma unroll
        for (int h2 = 0; h2 < 2; ++h2)
#pragma unroll
          for (int b = 0; b < 4; ++b) xv[h2][b] = *(const GAS f32x4*)(xt + (size_t)(rloc + h2 * 16) * 1024 + cb + b * 16);
#pragma unroll
        for (int h2 = 0; h2 < 2; ++h2) {
          const int a = a2 * 2 + h2;
          float s = 0.f, ss = 0.f;
#pragma unroll
          for (int b = 0; b < 4; ++b)
#pragma unroll
            for (int jj = 0; jj < 4; ++jj) { const float v = ALPHA_F * xv[h2][b][jj] + gv[b][jj] * acc[a][b][jj]; acc[a][b][jj] = v; s += v; ss += v * v; }
          s += __shfl_xor(s, 16); ss += __shfl_xor(ss, 16);
          s += __shfl_xor(s, 32); ss += __shfl_xor(ss, 32);
          if (lq == 0) { sRed[((rloc + h2 * 16) * 4 + wn) * 2] = s; sRed[((rloc + h2 * 16) * 4 + wn) * 2 + 1] = ss; }
        }
        __builtin_amdgcn_sched_barrier(0);
      }
    }
    __syncthreads();
    if (tid < 256) {
      const f32x4 u0 = *reinterpret_cast<const f32x4*>(sRed + tid * 8), u1 = *reinterpret_cast<const f32x4*>(sRed + tid * 8 + 4);
      float* sp = p.stats + ((size_t)(row0 + tid) * 4 + nt) * 2;
      sp[0] = u0[0] + u0[2] + u1[0] + u1[2]; sp[1] = u0[1] + u0[3] + u1[1] + u1[3];
    }
    asm volatile("s_waitcnt vmcnt(0)" ::: "memory");
    __syncthreads();
    if (tid == 0) {
      unsigned* cnt = p.bar + PAN_WORD(l * 2 + which, mt);
      __builtin_amdgcn_fence(__ATOMIC_RELEASE, "agent");
      asm volatile("s_waitcnt vmcnt(0)" ::: "memory");
      (void)__hip_atomic_fetch_add(cnt, 1u, __ATOMIC_RELAXED, __HIP_MEMORY_SCOPE_AGENT);
      unsigned sp_ = 0;
      while (__hip_atomic_load(cnt, __ATOMIC_RELAXED, __HIP_MEMORY_SCOPE_AGENT) < 4u && sp_ < (1u << 22)) { __builtin_amdgcn_s_sleep(1); ++sp_; }
      __builtin_amdgcn_fence(__ATOMIC_ACQUIRE, "agent");
      asm volatile("s_waitcnt vmcnt(0)" ::: "memory");
    }
    __syncthreads();
    {
      const float* lg = p.ln_g + (l * 2 + which) * 1024 + cb; const float* lb = p.ln_b + (l * 2 + which) * 1024 + cb;
      const float* md = (which == 0 ? p.mod + (l * 3 + cv) * 6144 + 3072 : p.mod + ((l + 1 < 2 ? l + 1 : l) * 3 + cv) * 6144) + cb;
#pragma unroll
      for (int a2 = 0; a2 < 4; ++a2) {
        int rloc = wm * 128 + a2 * 32 + lc;
        asm volatile("" : "+v"(rloc));
#pragma unroll
        for (int h2 = 0; h2 < 2; ++h2) {
          const int a = a2 * 2 + h2; const int row = row0 + rloc + h2 * 16;
          const f32x4 t0 = *(const GAS f32x4*)(p.stats + (size_t)row * 8), t1 = *(const GAS f32x4*)(p.stats + (size_t)row * 8 + 4);
          const float s = t0[0] + t0[2] + t1[0] + t1[2], ss = t0[1] + t0[3] + t1[1] + t1[3];
          const float mean = s * (1.f / 1024.f); const float var = fmaxf(ss * (1.f / 1024.f) - mean * mean, 0.f); const float rstd = rsqrtf(var + EPS_F);
#pragma unroll
          for (int b = 0; b < 4; ++b) {
            const f32x4 g4 = *(const GAS f32x4*)(lg + b * 16), b4 = *(const GAS f32x4*)(lb + b * 16);
            f32x4 x;
#pragma unroll
            for (int jj = 0; jj < 4; ++jj) x[jj] = (acc[a][b][jj] - mean) * rstd * g4[jj] + b4[jj];
            *(GAS f32x4*)(p.out + (size_t)row * 1024 + cb + b * 16) = x;
            if (has_next) {
              const f32x4 sh = *(const GAS f32x4*)(md + b * 16), sc = *(const GAS f32x4*)(md + 1024 + b * 16);
              uint2 o; o.x = pack2(x[0] * (1.f + sc[0]) + sh[0], x[1] * (1.f + sc[1]) + sh[1]); o.y = pack2(x[2] * (1.f + sc[2]) + sh[2], x[3] * (1.f + sc[3]) + sh[3]);
              *reinterpret_cast<uint2*>(p.h + (size_t)row * 1024 + cb + b * 16) = o;
            }
          }
        }
        __builtin_amdgcn_sched_barrier(0);
      }
    }
    __syncthreads();
  }
}

DI void phase_ln(const Params& p, int l, int which, char* smem, int bid, int nb) {
  const int lane = tidx() & 63, wid = tidx() >> 6;
  const bool has_next = (which == 0) || (l + 1 < 2);
  f32x4 gvv[4], bvv[4];
#pragma unroll
  for (int it = 0; it < 4; ++it) {
    gvv[it] = *(const GAS f32x4*)(p.ln_g + (l * 2 + which) * 1024 + it * 256 + lane * 4);
    bvv[it] = *(const GAS f32x4*)(p.ln_b + (l * 2 + which) * 1024 + it * 256 + lane * 4);
  }
  for (int row = bid * 4 + wid; row < NTOK; row += nb * 4) {
    float s = 0.f, ss = 0.f;
    if (lane < 16) { const float* sp = p.stats + ((size_t)row * 16 + lane) * 2; s = sp[0]; ss = sp[1]; }
    const float* md = which == 0 ? p.mod + (l * 3 + tok_cv(row)) * 6144 + 3072 : p.mod + ((l + 1 < 2 ? l + 1 : l) * 3 + tok_cv(row)) * 6144;
    float* xr = p.out + (size_t)row * 1024;
    f32x4 vin[4], shv[4], scv[4];
#pragma unroll
    for (int it = 0; it < 4; ++it) {
      vin[it] = *(const GAS f32x4*)(xr + it * 256 + lane * 4);
      shv[it] = *(const GAS f32x4*)(md + it * 256 + lane * 4);
      scv[it] = *(const GAS f32x4*)(md + 1024 + it * 256 + lane * 4);
    }
#pragma unroll
    for (int m = 1; m < 16; m <<= 1) { s += __shfl_xor(s, m); ss += __shfl_xor(ss, m); }
    s = __shfl(s, 0); ss = __shfl(ss, 0);
    const float mean = s * (1.f / 1024.f); const float var = fmaxf(ss * (1.f / 1024.f) - mean * mean, 0.f); const float rstd = rsqrtf(var + EPS_F);
#pragma unroll
    for (int it = 0; it < 4; ++it) {
      const int col = it * 256 + lane * 4;
      f32x4 v;
#pragma unroll
      for (int e = 0; e < 4; ++e) v[e] = (vin[it][e] - mean) * rstd * gvv[it][e] + bvv[it][e];
      *(GAS f32x4*)(xr + col) = v;
      if (has_next) {
        uint2 o; o.x = pack2(v[0] * (1.f + scv[it][0]) + shv[it][0], v[1] * (1.f + scv[it][1]) + shv[it][1]);
        o.y = pack2(v[2] * (1.f + scv[it][2]) + shv[it][2], v[3] * (1.f + scv[it][3]) + shv[it][3]);
        *reinterpret_cast<uint2*>(p.h + (size_t)row * 1024 + col) = o;
      }
    }
  }
  if (which == 1 && l == 0) {
    for (int it = bid; it < N_CONV_ITEMS; it += nb) conv_item(p, 1, it, smem);
  }
}

DI void phase_p5(const Params& p, int l, char* smem, int bid, int nb) {
  u16* U = p.proj;
  float* sA = reinterpret_cast<float*>(smem);
  const int ntiles = 49 * 22;
  for (int k = 0;; ++k) {
    const int it = xcd_tile(k, bid, nb);
    if (k * nb >= ntiles) break;
    if (it >= ntiles) continue;
    int mt, nt; tile_mn(it, 49, 22, mt, nt);
    const int g0 = mt * 254 - 1;
    f32x4 acc[8][4]; zero_acc<8>(acc);
    gemm_main<8>(acc, p.h, 1024, g0, NTOK - 1, p.WupT, 1024, nt * 256, 1024, smem);
    const int tid = rtid(), lane = tid & 63, wid = tid >> 6, wm = wid >> 2, wn = wid & 3, lq = lane >> 4, lc = lane & 15;
    float* sbase = sA + (wm * 128 + lq * 4) * 128 + (wn & 1) * 64 + lc;
    if (wn < 2) {
#pragma unroll
      for (int a = 0; a < 8; ++a)
#pragma unroll
        for (int b = 0; b < 4; ++b)
#pragma unroll
          for (int j = 0; j < 4; ++j) sbase[a * 2048 + j * 128 + b * 16] = acc[a][b][j];
    }
    __syncthreads();
    if (wn >= 2) {
      float w0[4], w1[4], w2[4], cbv[4];
#pragma unroll
      for (int b = 0; b < 4; ++b) { const int ch = nt * 128 + (wn - 2) * 64 + b * 16 + lc;
        w0[b] = p.ffn_conv_w[(l * 3 + 0) * 2816 + ch]; w1[b] = p.ffn_conv_w[(l * 3 + 1) * 2816 + ch]; w2[b] = p.ffn_conv_w[(l * 3 + 2) * 2816 + ch]; cbv[b] = p.ffn_conv_b[l * 2816 + ch]; }
      u16* ub = U + nt * 128 + (wn - 2) * 64 + lc;
#pragma unroll
      for (int a = 0; a < 8; ++a) {
#pragma unroll
        for (int j = 0; j < 4; ++j) {
          const int r = wm * 128 + a * 16 + lq * 4 + j; const int g = g0 + r;
          if (r >= 1 && r <= 254 && g < NTOK) {
            const bool st = g < 4096 ? ((g & 255) == 0) : ((g & 4095) == 0);
            const bool en = g < 4096 ? ((g & 255) == 255) : ((g & 4095) == 4095);
#pragma unroll
            for (int b = 0; b < 4; ++b) {
              const float* sp = sbase + a * 2048 + j * 128 + b * 16;
              const float ap = st ? 0.f : sp[-128];
              const float ac = sp[0];
              const float an = en ? 0.f : sp[128];
              const float cv = ap * w0[b] + ac * w1[b] + an * w2[b] + cbv[b];
              ub[(size_t)g * 2816 + b * 16] = f2bf(geluf_(cv) * acc[a][b][j]);
            }
          }
        }
        __builtin_amdgcn_sched_barrier(0);
      }
    }
    __syncthreads();
  }
}

DI void run_phase(int ph, char* smem_all, int rbid, int rnb) {
  const int half = __builtin_amdgcn_readfirstlane((int)(threadIdx.x >> 8));
  char* smem = smem_all + half * 65536; const int bid = rbid * 2 + half, nb = rnb * 2;
  unsigned long long ka = (unsigned long long)__builtin_amdgcn_kernarg_segment_ptr();
  asm volatile("" : "+s"(ka));
  const __attribute__((address_space(4))) Params& pk = *reinterpret_cast<const __attribute__((address_space(4))) Params*>(ka);
  Params p;
  p.x_prompt = (const float*)(const __attribute__((address_space(1))) float*)pk.x_prompt;
  p.x_sample = (const float*)(const __attribute__((address_space(1))) float*)pk.x_sample;
  p.cache_k = (const float*)(const __attribute__((address_space(1))) float*)pk.cache_k;
  p.cache_v = (const float*)(const __attribute__((address_space(1))) float*)pk.cache_v;
  p.state_ret = (const float*)(const __attribute__((address_space(1))) float*)pk.state_ret;
  p.state_gla = (const float*)(const __attribute__((address_space(1))) float*)pk.state_gla;
  p.c = (const float*)(const __attribute__((address_space(1))) float*)pk.c;
  p.c_ctx = (const float*)(const __attribute__((address_space(1))) float*)pk.c_ctx;
  p.ada_w = (const float*)(const __attribute__((address_space(1))) float*)pk.ada_w;
  p.ada_b = (const float*)(const __attribute__((address_space(1))) float*)pk.ada_b;
  p.w_in = (const float*)(const __attribute__((address_space(1))) float*)pk.w_in;
  p.ret_decay = (const float*)(const __attribute__((address_space(1))) float*)pk.ret_decay;
  p.gla_wa1 = (const float*)(const __attribute__((address_space(1))) float*)pk.gla_wa1;
  p.gla_wa2 = (const float*)(const __attribute__((address_space(1))) float*)pk.gla_wa2;
  p.gla_ba = (const float*)(const __attribute__((address_space(1))) float*)pk.gla_ba;
  p.gla_norm_g = (const float*)(const __attribute__((address_space(1))) float*)pk.gla_norm_g;
  p.diff_lam = (const float*)(const __attribute__((address_space(1))) float*)pk.diff_lam;
  p.diff_subln_g = (const float*)(const __attribute__((address_space(1))) float*)pk.diff_subln_g;
  p.w_branch = (const float*)(const __attribute__((address_space(1))) float*)pk.w_branch;
  p.w_out = (const float*)(const __attribute__((address_space(1))) float*)pk.w_out;
  p.ln_g = (const float*)(const __attribute__((address_space(1))) float*)pk.ln_g;
  p.ln_b = (const float*)(const __attribute__((address_space(1))) float*)pk.ln_b;
  p.ffn_w_up = (const float*)(const __attribute__((address_space(1))) float*)pk.ffn_w_up;
  p.ffn_conv_w = (const float*)(const __attribute__((address_space(1))) float*)pk.ffn_conv_w;
  p.ffn_conv_b = (const float*)(const __attribute__((address_space(1))) float*)pk.ffn_conv_b;
  p.ffn_w_down = (const float*)(const __attribute__((address_space(1))) float*)pk.ffn_w_down;
  p.out = (float*)(__attribute__((address_space(1))) float*)pk.out;
  p.dec = (float*)(__attribute__((address_space(1))) float*)pk.dec;
  p.r = (float*)(__attribute__((address_space(1))) float*)pk.r;
  p.stats = (float*)(__attribute__((address_space(1))) float*)pk.stats;
  p.mod = (float*)(__attribute__((address_space(1))) float*)pk.mod;
  p.rope = (float*)(__attribute__((address_space(1))) float*)pk.rope;
  p.lam = (float*)(__attribute__((address_space(1))) float*)pk.lam;
  p.WinT = (u16*)(__attribute__((address_space(1))) u16*)pk.WinT;
  p.WbT = (u16*)(__attribute__((address_space(1))) u16*)pk.WbT;
  p.WoT = (u16*)(__attribute__((address_space(1))) u16*)pk.WoT;
  p.WupT = (u16*)(__attribute__((address_space(1))) u16*)pk.WupT;
  p.WdT = (u16*)(__attribute__((address_space(1))) u16*)pk.WdT;
  p.proj = (u16*)(__attribute__((address_space(1))) u16*)pk.proj;
  p.Kc_p = (u16*)(__attribute__((address_space(1))) u16*)pk.Kc_p;
  p.VcT_p = (u16*)(__attribute__((address_space(1))) u16*)pk.VcT_p;
  p.Kc_s = (u16*)(__attribute__((address_space(1))) u16*)pk.Kc_s;
  p.VcT_s = (u16*)(__attribute__((address_space(1))) u16*)pk.VcT_s;
  p.h = (u16*)(__attribute__((address_space(1))) u16*)pk.h;
  p.scan = (u16*)(__attribute__((address_space(1))) u16*)pk.scan;
  p.bar = (unsigned*)(__attribute__((address_space(1))) unsigned*)pk.bar;
  if (ph == 0) { phase_pr0(p, smem, bid, nb); return; }
  if (ph == 1) { phase_pr1(p, bid, nb); return; }
  const int l = (ph - 2) / 10;
#ifdef ONLYS
  const int s = ONLYS;
#else
  const int s = (ph - 2) % 10;
#endif
  switch (s) {
    case 0: phase_p1(p, l, smem_all, rbid, rnb, bid, nb); break;
    case 1: phase_p2a(p, l, smem, bid, nb); break;
    case 2: phase_p2b(p, l, bid, nb); break;
    case 3: phase_p2c(p, l, smem_all, smem, rbid, rnb, bid, nb); break;
    case 4: phase_p3(p, l, smem_all, rbid, rnb); break;
    case 5: phase_res(p, l, 0, smem_all, rbid, rnb); break;
    case 6: break;
    case 7: phase_p5(p, l, smem_all, rbid, rnb); break;
    case 8: phase_res(p, l, 1, smem_all, rbid, rnb); break;
    default: if (l == 0) { for (int it = 1920 + bid; it < N_CONV_ITEMS; it += nb) conv_item(p, 1, it, smem); } break;
  }
}

#define XB_TMO      128
#define XB_XCNT(j)  (256  + 64 * (j))
#define XB_XSUB(j)  (1280 + 64 * (j))
#define XB_XGEN(j)  (2304 + 64 * (j))
#define XB_TOP      3328
#define XB_TOPGEN   3392
#define XCD_BAR_WORDS 3456
#define XB_SPIN_CAP (1u << 22)
#define LAS __attribute__((address_space(3)))
DI unsigned xb_ld(unsigned* p)              { return __hip_atomic_load(p, __ATOMIC_RELAXED, __HIP_MEMORY_SCOPE_AGENT); }
DI unsigned xb_add(unsigned* p, unsigned v) { return __hip_atomic_fetch_add(p, v, __ATOMIC_RELAXED, __HIP_MEMORY_SCOPE_AGENT); }
DI unsigned xb_xcc_id() { return (unsigned)__builtin_amdgcn_s_getreg((3 << 11) | 20) & 0xFu; }
#define XB_SPIN(cond, bar) do { unsigned _sp = 0; while (cond) { __builtin_amdgcn_s_sleep(1); \
    if ((++_sp & 255u) == 0u) { if (xb_ld(&(bar)[XB_TMO])) break; if (_sp > XB_SPIN_CAP) { atomicAdd(&(bar)[XB_TMO], 1u); break; } } } } while (0)
struct XcdBarrier { unsigned* bar; unsigned x; volatile LAS unsigned* st; };
DI XcdBarrier xcd_barrier_post(unsigned* bar, volatile LAS unsigned* st) {
  XcdBarrier b; b.bar = bar; b.x = xb_xcc_id(); b.st = st;
  if (threadIdx.x == 0) (void)xb_add(&bar[XB_XCNT(b.x)], 1u);
  return b;
}
DI void xcd_barrier_complete(unsigned* bar, unsigned x, unsigned& nloc, unsigned& nx) {
  const unsigned G = gridDim.x * gridDim.y * gridDim.z;
  unsigned sum, cnt, mine, sp = 0u;
  for (;;) {
    sum = 0u; cnt = 0u; mine = 0u;
#pragma unroll
    for (unsigned j = 0; j < 16; ++j) { const unsigned c = xb_ld(&bar[XB_XCNT(j)]); sum += c; cnt += (c > 0u) ? 1u : 0u; mine = (j == x) ? c : mine; }
    if (sum == G) break;
    __builtin_amdgcn_s_sleep(1);
    if ((++sp & 255u) == 0u) { if (xb_ld(&bar[XB_TMO])) break; if (sp > XB_SPIN_CAP) { atomicAdd(&bar[XB_TMO], 1u); break; } }
  }
  nloc = mine > 0u ? mine : 1u; nx = cnt > 0u ? cnt : 1u;
}
DI void xcd_barrier(const XcdBarrier& b) {
  asm volatile("s_waitcnt vmcnt(0)" ::: "memory");
  __syncthreads();
  if (threadIdx.x == 0) {
    unsigned* bar = b.bar;
    __builtin_amdgcn_s_waitcnt(0);
    unsigned nloc = b.st[0], nx = b.st[1];
    if (nloc == 0u) { xcd_barrier_complete(bar, b.x, nloc, nx); b.st[0] = nloc; b.st[1] = nx; }
    const unsigned old = xb_add(&bar[XB_XSUB(b.x)], 1u);
    const unsigned gen = old / nloc;
    if (old + 1u == (gen + 1u) * nloc) {
      __builtin_amdgcn_fence(__ATOMIC_RELEASE, "agent");
      asm volatile("s_waitcnt vmcnt(0)" ::: "memory");
      const unsigned og = xb_add(&bar[XB_TOP], 1u);
      const unsigned tg = og / nx;
      if (og + 1u == (tg + 1u) * nx) xb_add(&bar[XB_TOPGEN], 1u);
      else XB_SPIN(xb_ld(&bar[XB_TOPGEN]) == tg, bar);
      __builtin_amdgcn_fence(__ATOMIC_ACQUIRE, "agent");
      xb_add(&bar[XB_XGEN(b.x)], 1u);
      asm volatile("s_waitcnt vmcnt(0)" ::: "memory");
    } else {
      XB_SPIN(xb_ld(&bar[XB_XGEN(b.x)]) == gen, bar);
      __builtin_amdgcn_fence(__ATOMIC_ACQUIRE, "agent");
      asm volatile("s_waitcnt vmcnt(0)" ::: "memory");
    }
  }
  __syncthreads();
}

#define N_PHASES 22

__global__ void __launch_bounds__(512, 2) k_mega(Params p) {
  extern __shared__ __attribute__((aligned(16))) char smem[];
  __shared__ uint4 xb_words;
  cg::grid_group grid = cg::this_grid();
  if (threadIdx.x == 0) xb_words = make_uint4(0u, 0u, 0u, 0u);
  __syncthreads();
  XcdBarrier xb = xcd_barrier_post(p.bar, (volatile LAS unsigned*)&xb_words);
#define RUNPH(n_) do { int bid_ = blockIdx.x, nb_ = gridDim.x; asm volatile("" : "+s"(bid_), "+s"(nb_)); run_phase(n_, smem, bid_, nb_); } while (0)
#define GSYNC() xcd_barrier(xb)
  RUNPH(0); if (p.bar == nullptr) grid.sync(); else GSYNC(); RUNPH(1); GSYNC();
  RUNPH(2); GSYNC(); RUNPH(3); GSYNC(); RUNPH(4); GSYNC(); RUNPH(5); GSYNC(); RUNPH(6); GSYNC();
  RUNPH(7); GSYNC(); RUNPH(9); GSYNC(); RUNPH(10); GSYNC(); RUNPH(11); GSYNC();
  RUNPH(12); GSYNC(); RUNPH(13); GSYNC(); RUNPH(14); GSYNC(); RUNPH(15); GSYNC(); RUNPH(16); GSYNC();
  RUNPH(17); GSYNC(); RUNPH(19); GSYNC(); RUNPH(20);
}

extern "C" void kernel_launch(void* const* d_in, const int* in_sizes, int n_in, void* d_out, int out_size, void* d_ws, size_t ws_size, hipStream_t stream) {
  (void)in_sizes; (void)n_in; (void)out_size;
  Params p{};
  const float** f = reinterpret_cast<const float**>(&p);
  for (int i = 0; i < 26; ++i) f[i] = (const float*)d_in[i];
  p.out = (float*)d_out;
  char* w = (char*)d_ws; size_t off = 0;
  auto take = [&](size_t bytes) { char* r = w + off; off += (bytes + 255) & ~(size_t)255; return r; };
  p.WinT = (u16*)take((size_t)7936 * 1024 * 2);
  p.WbT = (u16*)take((size_t)3 * 1024 * 512 * 2);
  p.WoT = (u16*)take((size_t)1024 * 1024 * 2);
  p.WupT = (u16*)take((size_t)5632 * 1024 * 2);
  p.WdT = (u16*)take((size_t)1024 * 2816 * 2);
  p.proj = (u16*)take((size_t)NTOK * PLD * 2);
  p.Kc_p = (u16*)take((size_t)16 * 8 * 256 * 64 * 2);
  p.VcT_p = (u16*)take((size_t)16 * 4 * 128 * 256 * 2);
  p.Kc_s = (u16*)take((size_t)2 * 8 * 4352 * 64 * 2);
  p.VcT_s = (u16*)take((size_t)2 * 4 * 128 * 4352 * 2);
  p.h = (u16*)take((size_t)NTOK * 1024 * 2);
  p.scan = (u16*)take((size_t)2 * SCAN_MIX_ELEMS * 2);
  p.dec = (float*)take((size_t)2 * DEC_MIX * 4);
  p.r = (float*)take((size_t)NTOK * 32 * 4);
  p.stats = (float*)take((size_t)NTOK * 16 * 2 * 4);
  p.mod = (float*)take((size_t)2 * 3 * 6144 * 4);
  p.rope = (float*)take((size_t)64 * 16 * 2 * 4);
  p.lam = (float*)take(256);
  p.bar = (unsigned*)take((size_t)BAR_TOTAL_WORDS * 4);
  if (off > ws_size) { fprintf(stderr, "workspace too small: need %zu have %zu\n", off, ws_size); return; }
  constexpr size_t kDynLds = 131072;
  static int grid_blocks = 0;
  if (!grid_blocks) {
    int dev = 0, cus = 0, per_cu = 0;
    (void)hipGetDevice(&dev);
    (void)hipDeviceGetAttribute(&cus, hipDeviceAttributeMultiprocessorCount, dev);
    (void)hipFuncSetAttribute((const void*)k_mega, hipFuncAttributeMaxDynamicSharedMemorySize, (int)kDynLds);
    (void)hipOccupancyMaxActiveBlocksPerMultiprocessor(&per_cu, k_mega, 512, kDynLds);
    if (per_cu > 1) per_cu = 1;
    grid_blocks = cus * per_cu;
    grid_blocks &= ~7;
  }
  (void)hipMemsetAsync(p.bar, 0, (size_t)BAR_TOTAL_WORDS * 4, stream);
  void* args[] = {&p};
  hipError_t e = hipLaunchCooperativeKernel((void*)k_mega, dim3(grid_blocks), dim3(512), args, kDynLds, stream);
  if (e != hipSuccess) fprintf(stderr, "cooperative launch failed: %s (grid %d)\n", hipGetErrorString(e), grid_blocks);
}
```

```cpp
#include <hip/hip_runtime.h>
#include <hip/hip_cooperative_groups.h>
#include <cstdio>
namespace cg = cooperative_groups;

#ifndef MULTI_LAUNCH
#define MULTI_LAUNCH 0
#endif

typedef unsigned short u16;
using bf16x8 = __attribute__((ext_vector_type(8))) short;
using s16x4  = __attribute__((ext_vector_type(4))) short;
using f32x4  = __attribute__((ext_vector_type(4))) float;
using f32x16 = __attribute__((ext_vector_type(16))) float;
#define DI __device__ __forceinline__
#define GAS __attribute__((address_space(1)))
typedef const GAS unsigned short* gcu16p;
typedef unsigned u32x4 __attribute__((ext_vector_type(4)));
typedef const GAS u32x4* gcu4p;

#define NTOK 12288
#define PLD 3584
#define ALPHA_F 1.4142135623730951f
#define EPS_F 1e-5f
#define LOG2E_F 1.4426950408889634f

#define OUT_YS   4194304
#define OUT_DK   12582912
#define OUT_DV   16777216
#define OUT_SRET 20971520
#define OUT_SGLA 23068672

#define SCAN_MIX_ELEMS 12582912
#define SCAN_SAMPLE_OFF 4194304
#define DEC_MIX 98304
#define DEC_SAMPLE_OFF 32768

struct Params {
  const float *x_prompt, *x_sample, *cache_k, *cache_v, *state_ret, *state_gla, *c, *c_ctx;
  const float *ada_w, *ada_b, *w_in, *ret_decay, *gla_wa1, *gla_wa2, *gla_ba, *gla_norm_g, *diff_lam,
      *diff_subln_g, *w_branch, *w_out, *ln_g, *ln_b, *ffn_w_up, *ffn_conv_w, *ffn_conv_b, *ffn_w_down;
  float* out;
  u16 *WinT, *WbT, *WoT, *WupT, *WdT;
  u16 *proj, *Kc_p, *VcT_p, *Kc_s, *VcT_s, *h, *scan;
  float *dec, *r, *stats, *mod, *rope, *lam;
  unsigned* bar;
};

DI int rtid() { int t = __builtin_amdgcn_workitem_id_x(); asm volatile("" : "+v"(t)); return t; }
DI int tidx() { int t = __builtin_amdgcn_workitem_id_x() & 255; asm volatile("" : "+v"(t)); return t; }
typedef __bf16 bf2_t __attribute__((ext_vector_type(2)));
typedef float f2_t __attribute__((ext_vector_type(2)));
DI unsigned pack2(float a, float b) { f2_t v = {a, b}; return __builtin_bit_cast(unsigned, __builtin_convertvector(v, bf2_t)); }
DI u16 f2bf(float x) { return (u16)(pack2(x, 0.f) & 0xffffu); }
DI float bf2f(u16 b) { return __uint_as_float(((unsigned)b) << 16); }
DI float sigmoidf_(float x) { return __builtin_amdgcn_rcpf(1.f + __expf(-x)); }
DI float siluf_(float x) { return x * __builtin_amdgcn_rcpf(1.f + __expf(-x)); }
DI float logsigf_(float z) { return fminf(z, 0.f) - __logf(1.f + __expf(-fabsf(z))); }
DI float geluf_(float x) { float y = 0.7978845608028654f * (x + 0.044715f * x * x * x); float t = 1.f - 2.f * __builtin_amdgcn_rcpf(1.f + __expf(2.f * y)); return 0.5f * x * (1.f + t); }
DI int tok_cv(int tok) { return tok < 4096 ? 0 : 1 + ((tok - 4096) >> 12); }
DI f32x4 zero4() { f32x4 z = {0.f, 0.f, 0.f, 0.f}; return z; }
#define MFMA16(a, b, c) __builtin_amdgcn_mfma_f32_16x16x32_bf16((a), (b), (c), 0, 0, 0)
#define MFMA32(a, b, c) __builtin_amdgcn_mfma_f32_32x32x16_bf16((a), (b), (c), 0, 0, 0)
#define MFMA16P(a, b, c) ({ __builtin_amdgcn_s_setprio(1); f32x4 r_ = MFMA16((a), (b), (c)); __builtin_amdgcn_s_setprio(0); r_; })

struct GemmNext { const u16* A; int lda; const u16* B; int ldb; int n0; int bcs; int nbc; int m0; };
template <int MI, bool TR = false, int NJ = 4, bool PRE = false, bool NEXT = false>
DI void gemm_main(f32x4 (&acc)[MI][NJ], const u16* __restrict__ A, int lda, int m0, int mmax,
                  const u16* __restrict__ B, int ldb, int n0, int K, char* smem, int bcs = 64, GemmNext nx = GemmNext{}) {
  constexpr int NBC = MI == 8 ? 4 : (MI == 4 ? 2 : NJ / 4);
  const int tid = rtid(), lane = tid & 63, wid = tid >> 6;
  const int wro = MI == 8 ? (wid >> 2) * 128 : (MI == 4 ? (wid >> 1) * 64 : wid * 32);
  const int wco = MI == 8 ? (wid & 3) * 64 : (MI == 4 ? (wid & 1) * 64 : 0);
  const int lr = tid >> 3, lch = tid & 7;
  size_t aoff0, aoff1, aoff2, aoff3;
  { int r = m0 + lr; r = r < 0 ? 0 : (r > mmax ? mmax : r); aoff0 = (size_t)r * lda + lch * 8; }
  { int r = m0 + lr + 64; r = r < 0 ? 0 : (r > mmax ? mmax : r); aoff1 = (size_t)r * lda + lch * 8; }
  { int r = m0 + lr + 128; r = r < 0 ? 0 : (r > mmax ? mmax : r); aoff2 = (size_t)r * lda + lch * 8; }
  { int r = m0 + lr + 192; r = r < 0 ? 0 : (r > mmax ? mmax : r); aoff3 = (size_t)r * lda + lch * 8; }
  gcu16p Ag = (gcu16p)A;
  gcu16p bbase = (gcu16p)B + (size_t)(n0 + lr) * ldb + lch * 8;
  const int soff = lr * 128 + ((lch ^ ((lr >> 1) & 7)) << 4);
  const int lr16 = lane & 15, q = lane >> 4, swz = lr16 >> 1;
  const int c0 = ((q ^ swz) << 4);
  const int aro = (wro + lr16) * 128, bro = 32768 + (wco + lr16) * 128;
  u32x4 ra0, ra1, ra2, ra3, rb0, rb1, rb2, rb3;
  rb1 = (u32x4){0u, 0u, 0u, 0u}; rb2 = rb1; rb3 = rb1;
  const int nk = K >> 6;
#define G_LOAD(k0_) do { \
    ra0 = *(gcu4p)(Ag + aoff0 + (k0_)); ra1 = *(gcu4p)(Ag + aoff1 + (k0_)); \
    ra2 = *(gcu4p)(Ag + aoff2 + (k0_)); ra3 = *(gcu4p)(Ag + aoff3 + (k0_)); \
    rb0 = *(gcu4p)(bbase + (k0_)); \
    if (NBC >= 2) rb1 = *(gcu4p)(bbase + (size_t)bcs * ldb + (k0_)); \
    if (NBC >= 3) rb2 = *(gcu4p)(bbase + (size_t)(2 * bcs) * ldb + (k0_)); \
    if (NBC == 4) rb3 = *(gcu4p)(bbase + (size_t)(3 * bcs) * ldb + (k0_)); } while (0)
#define G_STORE(sw_) do { \
    *reinterpret_cast<u32x4*>((sw_) + soff) = ra0; *reinterpret_cast<u32x4*>((sw_) + soff + 8192) = ra1; \
    *reinterpret_cast<u32x4*>((sw_) + soff + 16384) = ra2; *reinterpret_cast<u32x4*>((sw_) + soff + 24576) = ra3; \
    *reinterpret_cast<u32x4*>((sw_) + 32768 + soff) = rb0; \
    if (NBC >= 2) *reinterpret_cast<u32x4*>((sw_) + 32768 + soff + 8192) = rb1; \
    if (NBC >= 3) *reinterpret_cast<u32x4*>((sw_) + 32768 + soff + 16384) = rb2; \
    if (NBC == 4) *reinterpret_cast<u32x4*>((sw_) + 32768 + soff + 24576) = rb3; } while (0)
#define LDA_(sb_, ks_, mi_) (*reinterpret_cast<const bf16x8*>((sb_) + aro + (mi_) * 2048 + (c0 ^ ((ks_) * 64))))
#define LDB_(sb_, ks_, ni_) (*reinterpret_cast<const bf16x8*>((sb_) + bro + (ni_) * 2048 + (c0 ^ ((ks_) * 64))))
#define G_SB() __builtin_amdgcn_sched_barrier(0)
#define G_STEP(sb_, s_) do { \
    if ((s_) + 3 < 16) ar[((s_) + 3) & 3] = LDA_(sb_, ((s_) + 3) >> 3, ((s_) + 3) & 7); \
    if ((s_) >= 4 && (s_) < 8) b1[((s_) - 4) & 3] = LDB_(sb_, 1, ((s_) - 4) & 3); \
    _Pragma("unroll") for (int ni = 0; ni < 4; ++ni) \
      acc[(s_) & (MI - 1)][ni] = TR ? MFMA16(((s_) >> 3) ? b1[ni] : b0[ni], ar[(s_) & 3], acc[(s_) & (MI - 1)][ni]) : MFMA16(ar[(s_) & 3], ((s_) >> 3) ? b1[ni] : b0[ni], acc[(s_) & (MI - 1)][ni]); \
    G_SB(); } while (0)
#define G_COMPUTE(sb_) do { \
    if (MI == 8) { \
      bf16x8 b0[4], b1[4], ar[4]; \
      _Pragma("unroll") for (int ni = 0; ni < 4; ++ni) b0[ni] = LDB_(sb_, 0, ni); \
      ar[0] = LDA_(sb_, 0, 0); ar[1] = LDA_(sb_, 0, 1); ar[2] = LDA_(sb_, 0, 2); \
      G_SB(); \
      G_STEP(sb_, 0); G_STEP(sb_, 1); G_STEP(sb_, 2); G_STEP(sb_, 3); G_STEP(sb_, 4); G_STEP(sb_, 5); G_STEP(sb_, 6); G_STEP(sb_, 7); \
      G_STEP(sb_, 8); G_STEP(sb_, 9); G_STEP(sb_, 10); G_STEP(sb_, 11); G_STEP(sb_, 12); G_STEP(sb_, 13); G_STEP(sb_, 14); G_STEP(sb_, 15); \
    } else if (NJ != 4) { \
      _Pragma("unroll") for (int ks = 0; ks < 2; ++ks) { \
        bf16x8 af2[MI]; \
        _Pragma("unroll") for (int mi = 0; mi < MI; ++mi) af2[mi] = LDA_(sb_, ks, mi); \
        _Pragma("unroll") for (int ni = 0; ni < NJ; ++ni) { \
          const bf16x8 bq = LDB_(sb_, ks, ni); \
          _Pragma("unroll") for (int mi = 0; mi < MI; ++mi) acc[mi][ni] = MFMA16(af2[mi], bq, acc[mi][ni]); } } \
    } else { \
      _Pragma("unroll") for (int ks = 0; ks < 2; ++ks) { \
        bf16x8 af[MI], bfr[4]; \
        _Pragma("unroll") for (int mi = 0; mi < MI; ++mi) af[mi] = LDA_(sb_, ks, mi); \
        _Pragma("unroll") for (int ni = 0; ni < 4; ++ni) bfr[ni] = LDB_(sb_, ks, ni); \
        _Pragma("unroll") for (int mi = 0; mi < MI; ++mi) \
          _Pragma("unroll") for (int ni = 0; ni < 4; ++ni) acc[mi][ni] = TR ? MFMA16(bfr[ni], af[mi], acc[mi][ni]) : MFMA16(af[mi], bfr[ni], acc[mi][ni]); } \
    } } while (0)
#define G_BAR() asm volatile("s_waitcnt lgkmcnt(0)\n\ts_barrier" ::: "memory")
  const int klast = K - 64;
#ifndef NO_GLDS
  {
    const int sw8 = ((lch ^ ((lr >> 1) & 7)) - lch) * 8;
    typedef __attribute__((address_space(3))) unsigned* ldsu;
    ldsu lbase = (ldsu)(smem) + wid * 256;
#define G_DMA(stage_, k0_) do { \
      ldsu lb_ = lbase + (stage_) * 16384; \
      __builtin_amdgcn_global_load_lds((const GAS unsigned*)(Ag + aoff0 + sw8 + (k0_)), lb_, 16, 0, 0); \
      __builtin_amdgcn_global_load_lds((const GAS unsigned*)(Ag + aoff1 + sw8 + (k0_)), lb_ + 2048, 16, 0, 0); \
      __builtin_amdgcn_global_load_lds((const GAS unsigned*)(Ag + aoff2 + sw8 + (k0_)), lb_ + 4096, 16, 0, 0); \
      __builtin_amdgcn_global_load_lds((const GAS unsigned*)(Ag + aoff3 + sw8 + (k0_)), lb_ + 6144, 16, 0, 0); \
      __builtin_amdgcn_global_load_lds((const GAS unsigned*)(bbase + sw8 + (k0_)), lb_ + 8192, 16, 0, 0); \
      if (NBC >= 2) __builtin_amdgcn_global_load_lds((const GAS unsigned*)(bbase + (size_t)bcs * ldb + sw8 + (k0_)), lb_ + 8192 + 2048, 16, 0, 0); \
      if (NBC >= 3) __builtin_amdgcn_global_load_lds((const GAS unsigned*)(bbase + (size_t)(2 * bcs) * ldb + sw8 + (k0_)), lb_ + 8192 + 4096, 16, 0, 0); \
      if (NBC == 4) __builtin_amdgcn_global_load_lds((const GAS unsigned*)(bbase + (size_t)(3 * bcs) * ldb + sw8 + (k0_)), lb_ + 8192 + 6144, 16, 0, 0); } while (0)
#define G_BARV() asm volatile("s_waitcnt vmcnt(0) lgkmcnt(0)\n\ts_barrier" ::: "memory")
    if (!PRE) { G_DMA(0, 0); G_BARV(); }
#pragma unroll 1
    for (int kt = 0; kt < nk; ++kt) {
      if (NEXT && kt == nk - 1) {
        gcu16p An = (gcu16p)nx.A; gcu16p Bn = (gcu16p)nx.B + (size_t)(nx.n0 + lr) * nx.ldb + lch * 8 + sw8;
        ldsu lb_ = lbase;
#define G_NROW(i_) ({ int r_ = nx.m0 + lr + 64 * (i_); r_ = r_ < 0 ? 0 : (r_ > mmax ? mmax : r_); (size_t)r_ * nx.lda + lch * 8 + sw8; })
        __builtin_amdgcn_global_load_lds((const GAS unsigned*)(An + G_NROW(0)), lb_, 16, 0, 0);
        __builtin_amdgcn_global_load_lds((const GAS unsigned*)(An + G_NROW(1)), lb_ + 2048, 16, 0, 0);
        __builtin_amdgcn_global_load_lds((const GAS unsigned*)(An + G_NROW(2)), lb_ + 4096, 16, 0, 0);
        __builtin_amdgcn_global_load_lds((const GAS unsigned*)(An + G_NROW(3)), lb_ + 6144, 16, 0, 0);
        __builtin_amdgcn_global_load_lds((const GAS unsigned*)(Bn), lb_ + 8192, 16, 0, 0);
        if (nx.nbc >= 2) __builtin_amdgcn_global_load_lds((const GAS unsigned*)(Bn + (size_t)nx.bcs * nx.ldb), lb_ + 8192 + 2048, 16, 0, 0);
        if (nx.nbc >= 3) __builtin_amdgcn_global_load_lds((const GAS unsigned*)(Bn + (size_t)(2 * nx.bcs) * nx.ldb), lb_ + 8192 + 4096, 16, 0, 0);
        if (nx.nbc >= 4) __builtin_amdgcn_global_load_lds((const GAS unsigned*)(Bn + (size_t)(3 * nx.bcs) * nx.ldb), lb_ + 8192 + 6144, 16, 0, 0);
      } else {
        int k1 = (kt + 1) << 6; k1 = k1 > klast ? klast : k1; G_DMA((kt + 1) & 1, k1);
      }
      G_COMPUTE(smem + (kt & 1) * 65536);
      G_BARV();
    }
    if (!NEXT) __syncthreads();
    return;
  }
#endif
  G_LOAD(0);
  G_STORE(smem);
  G_LOAD(64);
  __syncthreads();
#pragma unroll 1
  for (int kt = 0; kt < nk; ++kt) {
    const char* sb = smem + (kt & 1) * 65536;
    char* sw = smem + ((kt + 1) & 1) * 65536;
    G_COMPUTE(sb);
    G_STORE(sw);
    G_BAR();
    { int k2 = (kt + 2) << 6; k2 = k2 > klast ? klast : k2; G_LOAD(k2); }
  }
  __syncthreads();
}

DI int xcd_tile(int k, int bid, int nb) { const int per = nb >> 3; return (k * 8 + (bid & 7)) * per + (bid >> 3); }
DI void tile_mn(int L, int MT, int NT, int& mt, int& nt) {
  const int g = L / (8 * NT), w = L - g * 8 * NT; const int gsz = (MT - g * 8) < 8 ? (MT - g * 8) : 8;
  nt = w / gsz; mt = g * 8 + (w - nt * gsz);
}

template <int MI, int NJ = 4>
DI void zero_acc(f32x4 (&acc)[MI][NJ]) {
#pragma unroll
  for (int i = 0; i < MI; ++i)
#pragma unroll
    for (int j = 0; j < NJ; ++j) acc[i][j] = zero4();
}

DI void conv_tile(const float* __restrict__ src, int ldn, int c0, int k0, u16* __restrict__ dst, int ldk, int r0, char* smem) {
  float* t = reinterpret_cast<float*>(smem);
  const int tid = tidx();
#pragma unroll
  for (int it = 0; it < 16; ++it) { int idx = tid + 256 * it; int kk = idx >> 6, cc = idx & 63; t[kk * 65 + cc] = src[(size_t)(k0 + kk) * ldn + c0 + cc]; }
  __syncthreads();
#pragma unroll
  for (int it = 0; it < 2; ++it) {
    int ch = tid + 256 * it; int n = ch >> 3, kc = ch & 7;
    uint4 v;
    v.x = pack2(t[(kc * 8 + 0) * 65 + n], t[(kc * 8 + 1) * 65 + n]);
    v.y = pack2(t[(kc * 8 + 2) * 65 + n], t[(kc * 8 + 3) * 65 + n]);
    v.z = pack2(t[(kc * 8 + 4) * 65 + n], t[(kc * 8 + 5) * 65 + n]);
    v.w = pack2(t[(kc * 8 + 6) * 65 + n], t[(kc * 8 + 7) * 65 + n]);
    *reinterpret_cast<uint4*>(dst + (size_t)(r0 + n) * ldk + k0 + kc * 8) = v;
  }
  __syncthreads();
}

#define N_CONV_ITEMS 4800
DI void conv_item(const Params& p, int l, int it, char* smem) {
  if (it < 1920) { int nb = it >> 4, kb = it & 15; conv_tile(p.w_in + (size_t)l * 1024 * 7680, 7680, nb * 64, kb * 64, p.WinT, 1024, nb * 64, smem); return; }
  it -= 1920;
  if (it < 384) { int i = it >> 7, r = it & 127; int nb = r >> 3, kb = r & 7;
    conv_tile(p.w_branch + (size_t)(l * 3 + i) * 512 * 1024, 1024, nb * 64, kb * 64, p.WbT + (size_t)i * 1024 * 512, 512, nb * 64, smem); return; }
  it -= 384;
  if (it < 256) { int nb = it >> 4, kb = it & 15; conv_tile(p.w_out + (size_t)l * 1024 * 1024, 1024, nb * 64, kb * 64, p.WoT, 1024, nb * 64, smem); return; }
  it -= 256;
  if (it < 1408) { int nb = it >> 4, kb = it & 15; const int tl = nb >> 2, w = nb & 3; int c0 = w < 2 ? tl * 128 + w * 64 : 2816 + tl * 128 + (w - 2) * 64;
    conv_tile(p.ffn_w_up + (size_t)l * 1024 * 5632, 5632, c0, kb * 64, p.WupT, 1024, nb * 64, smem); return; }
  it -= 1408;
  if (it < 704) { int nb = it / 44, kb = it % 44; conv_tile(p.ffn_w_down + (size_t)l * 2816 * 1024, 1024, nb * 64, kb * 64, p.WdT, 2816, nb * 64, smem); return; }
  it -= 704;
  for (int e = tidx(); e < 2048; e += 256) {
    int idx = it * 2048 + e; int row = idx >> 10, k = idx & 1023;
    float v = row < 32 ? p.gla_wa1[(((size_t)l * 2 + (row >> 4)) * 1024 + k) * 16 + (row & 15)] : 0.f;
    p.WinT[(size_t)(7680 + row) * 1024 + k] = f2bf(v);
  }
}

DI void ada_item(const Params& p, int it, char* smem) {
  const int l = it / 96, cb = it % 96, tid = tidx();
  float* ssil = reinterpret_cast<float*>(smem);
  float* red = ssil + 3072;
  for (int i = tid; i < 3072; i += 256) { int j = i >> 10, k = i & 1023; float v = j == 0 ? p.c_ctx[k] : p.c[(j - 1) * 1024 + k]; ssil[i] = siluf_(v); }
  __syncthreads();
  const int c = tid & 63, kg = tid >> 6;
  const float* w = p.ada_w + (size_t)l * 1024 * 6144 + cb * 64 + c;
  float a0 = 0.f, a1 = 0.f, a2 = 0.f;
#pragma unroll 32
  for (int k = kg * 256; k < kg * 256 + 256; ++k) { float wv = w[(size_t)k * 6144]; a0 += ssil[k] * wv; a1 += ssil[1024 + k] * wv; a2 += ssil[2048 + k] * wv; }
  red[(kg * 3 + 0) * 64 + c] = a0; red[(kg * 3 + 1) * 64 + c] = a1; red[(kg * 3 + 2) * 64 + c] = a2;
  __syncthreads();
  if (tid < 192) { int j = tid >> 6; float s = p.ada_b[l * 6144 + cb * 64 + c];
    for (int g = 0; g < 4; ++g) s += red[(g * 3 + j) * 64 + c];
    p.mod[(l * 3 + j) * 6144 + cb * 64 + c] = s; }
  __syncthreads();
}

DI void misc_item(const Params& p) {
  const int tid = tidx();
  if (tid < 16) {
    int a = tid >> 2, b = tid & 3;
    double th = (b == 0 ? 1.0 : b == 1 ? 0.5623413251903491 : b == 2 ? 0.31622776601683794 : 0.1778279410038923);
    th *= (a == 0 ? 1.0 : a == 1 ? 0.1 : a == 2 ? 0.01 : 0.001);
    double t2 = th * th, cs = 1.0, sn = th, tc = 1.0, ts = th;
    for (int n = 1; n < 14; ++n) { tc *= -t2 / ((2.0 * n - 1.0) * (2.0 * n)); cs += tc; ts *= -t2 / ((2.0 * n) * (2.0 * n + 1.0)); sn += ts; }
    double c = 1.0, s = 0.0;
    for (int pos = 0; pos < 64; ++pos) { p.rope[(pos * 16 + tid) * 2] = (float)c; p.rope[(pos * 16 + tid) * 2 + 1] = (float)s; double cn = c * cs - s * sn; s = s * cs + c * sn; c = cn; }
  } else if (tid == 32 || tid == 33) {
    int l = tid - 32; const float* lp = p.diff_lam + l * 256; float s1 = 0.f, s2 = 0.f;
    for (int d = 0; d < 64; ++d) { s1 += lp[d] * lp[64 + d]; s2 += lp[128 + d] * lp[192 + d]; }
    float li = 0.8f - 0.6f * expf(-0.3f * (float)l);
    p.lam[l * 2] = expf(s1) - expf(s2) + li; p.lam[l * 2 + 1] = li;
  }
}

DI void phase_pr0(const Params& p, char* smem, int bid, int nb) {
  if (bid == 0) misc_item(p);
  const int total = N_CONV_ITEMS + 192;
  for (int it = bid; it < total; it += nb) {
    if (it < 192) ada_item(p, it, smem);
    else conv_item(p, 0, it - 192, smem);
  }
}

DI void phase_pr1(const Params& p, int bid, int nb) {
  const int lane = tidx() & 63, wid = tidx() >> 6;
  for (int row = bid * 4 + wid; row < NTOK; row += nb * 4) {
    const float* xr = row < 4096 ? p.x_prompt + (size_t)row * 1024 : p.x_sample + (size_t)(row - 4096) * 1024;
    const float* md = p.mod + (0 * 3 + tok_cv(row)) * 6144;
    f32x4 vin[4], shv[4], scv[4];
#pragma unroll
    for (int it = 0; it < 4; ++it) { vin[it] = *(const GAS f32x4*)(xr + it * 256 + lane * 4);
      shv[it] = *(const GAS f32x4*)(md + it * 256 + lane * 4); scv[it] = *(const GAS f32x4*)(md + 1024 + it * 256 + lane * 4); }
#pragma unroll
    for (int it = 0; it < 4; ++it) {
      int col = it * 256 + lane * 4;
      float4 v; v.x = vin[it][0]; v.y = vin[it][1]; v.z = vin[it][2]; v.w = vin[it][3];
      float4 sh, sc; sh.x = shv[it][0]; sh.y = shv[it][1]; sh.z = shv[it][2]; sh.w = shv[it][3]; sc.x = scv[it][0]; sc.y = scv[it][1]; sc.z = scv[it][2]; sc.w = scv[it][3];
      uint2 o; o.x = pack2(v.x * (1.f + sc.x) + sh.x, v.y * (1.f + sc.y) + sh.y); o.y = pack2(v.z * (1.f + sc.z) + sh.z, v.w * (1.f + sc.w) + sh.w);
      *reinterpret_cast<uint2*>(p.h + (size_t)row * 1024 + col) = o;
    }
  }
}

DI void rot(float& a, float& b, float c, float s) { float na = a * c - b * s; b = b * c + a * s; a = na; }

DI void epi_p1(const Params& p, int l, f32x4 (&acc)[8][4], int m0, int nt) {
  const int lane = rtid() & 63, wid = rtid() >> 6, wm = wid >> 2, wn = wid & 3;
  const int lq = lane >> 4, lc = lane & 15;
  const int rbase = m0 + wm * 128;
  if (nt == 18) {
    if (wn == 0) {
#pragma unroll
      for (int mi = 0; mi < 8; ++mi)
#pragma unroll
        for (int j = 0; j < 4; ++j) { int tok = rbase + mi * 16 + lq * 4 + j; p.r[tok * 32 + lc] = acc[mi][0][j]; p.r[tok * 32 + 16 + lc] = acc[mi][1][j]; }
    }
    return;
  }
  const int cb = nt * 256 + wn * 64;
  if (cb >= 4096) {
    const int head = (cb - 4096) >> 7, dvb = (cb - 4096) & 127;
#pragma unroll
    for (int mi = 0; mi < 8; ++mi) {
      const int tok0 = rbase + mi * 16 + lq * 4;
#pragma unroll
      for (int ni = 0; ni < 4; ++ni) {
        const int dv = dvb + ni * 16 + lc;
        uint2 o; o.x = pack2(acc[mi][ni][0], acc[mi][ni][1]); o.y = pack2(acc[mi][ni][2], acc[mi][ni][3]);
        if (tok0 < 4096) {
          int b = tok0 >> 8, t = tok0 & 255;
          *reinterpret_cast<uint2*>(p.VcT_p + ((size_t)(b * 4 + head) * 128 + dv) * 256 + t) = o;
          float* ov = p.out + OUT_DV + ((size_t)((b * 2 + l) * 4 + head) * 256 + t) * 128 + dv;
#pragma unroll
          for (int j = 0; j < 4; ++j) ov[j * 128] = acc[mi][ni][j];
        } else {
          int bs = (tok0 - 4096) >> 12, t = (tok0 - 4096) & 4095;
          *reinterpret_cast<uint2*>(p.VcT_s + ((size_t)(bs * 4 + head) * 128 + dv) * 4352 + 256 + t) = o;
        }
      }
    }
    return;
  }
  const bool rope = (cb < 512) || (cb >= 3072);
  const float scale = ((cb >= 256 && cb < 512) || (cb >= 1536 && cb < 1792)) ? 0.125f : (cb >= 3072 && cb < 3584) ? 0.125f * LOG2E_F : 1.f;
  const bool dorope = rope && (m0 >= 4096);
#pragma unroll
  for (int mi = 0; mi < 8; ++mi) {
    float2 ra = make_float2(1.f, 0.f), rb4[4];
#pragma unroll
    for (int j = 0; j < 4; ++j) rb4[j] = make_float2(1.f, 0.f);
    if (dorope) {
      const int t0 = (rbase + mi * 16 + lq * 4 - 4096) & 4095;
      ra = *reinterpret_cast<const float2*>(p.rope + ((t0 >> 6) * 16 + lc) * 2);
#pragma unroll
      for (int j = 0; j < 4; ++j) rb4[j] = *reinterpret_cast<const float2*>(p.rope + (((t0 & 63) + j) * 16 + lc) * 2);
    }
#pragma unroll
    for (int j = 0; j < 4; ++j) {
      const int tok = rbase + mi * 16 + lq * 4 + j;
      float v0 = acc[mi][0][j] * scale, v1 = acc[mi][1][j] * scale, v2 = acc[mi][2][j] * scale, v3 = acc[mi][3][j] * scale;
      if (dorope) { rot(v0, v1, ra.x, ra.y); rot(v2, v3, rb4[j].x, rb4[j].y); }
      if (cb < 3584) {
        u16* d = p.proj + (size_t)tok * PLD + cb + lc;
        d[0] = f2bf(v0); d[16] = f2bf(v1); d[32] = f2bf(v2); d[48] = f2bf(v3);
      } else {
        const int g = (cb - 3584) >> 6;
        if (tok < 4096) {
          int b = tok >> 8, t = tok & 255;
          u16* d = p.Kc_p + ((size_t)(b * 8 + g) * 256 + t) * 64 + lc;
          d[0] = f2bf(v0); d[16] = f2bf(v1); d[32] = f2bf(v2); d[48] = f2bf(v3);
          float* o = p.out + OUT_DK + ((size_t)((b * 2 + l) * 8 + g) * 256 + t) * 64 + lc;
          o[0] = v0; o[16] = v1; o[32] = v2; o[48] = v3;
        } else {
          int bs = (tok - 4096) >> 12, t = (tok - 4096) & 4095;
          u16* d = p.Kc_s + ((size_t)(bs * 8 + g) * 4352 + 256 + t) * 64 + lc;
          d[0] = f2bf(v0); d[16] = f2bf(v1); d[32] = f2bf(v2); d[48] = f2bf(v3);
        }
      }
    }
  }
}

DI void ctx_item(const Params& p, int l, int it) {
  const int tid = tidx();
  if (it < 64) {
#pragma unroll
    for (int e0 = 0; e0 < 4096; e0 += 2048) {
      float v[8];
#pragma unroll
      for (int k = 0; k < 8; ++k) { const int idx = it * 4096 + e0 + k * 256 + tid;
        const int d = idx & 63, pos = (idx >> 6) & 255, g = (idx >> 14) & 7, b = idx >> 17;
        v[k] = ((const GAS float*)p.cache_k)[((size_t)((b * 2 + l) * 8 + g) * 256 + pos) * 64 + d]; }
#pragma unroll
      for (int k = 0; k < 8; ++k) { const int idx = it * 4096 + e0 + k * 256 + tid;
        const int d = idx & 63, pos = (idx >> 6) & 255, g = (idx >> 14) & 7, b = idx >> 17;
        p.Kc_s[((size_t)(b * 8 + g) * 4352 + pos) * 64 + d] = f2bf(v[k]); }
    }
  } else {
    it -= 64;
#pragma unroll
    for (int e0 = 0; e0 < 4096; e0 += 2048) {
      float v[8];
#pragma unroll
      for (int k = 0; k < 8; ++k) { const int idx = it * 4096 + e0 + k * 256 + tid;
        const int dv = idx & 127, pos = (idx >> 7) & 255, hd = (idx >> 15) & 3, b = idx >> 17;
        v[k] = ((const GAS float*)p.cache_v)[((size_t)((b * 2 + l) * 4 + hd) * 256 + pos) * 128 + dv]; }
#pragma unroll
      for (int k = 0; k < 8; ++k) { const int idx = it * 4096 + e0 + k * 256 + tid;
        const int dv = idx & 127, pos = (idx >> 7) & 255, hd = (idx >> 15) & 3, b = idx >> 17;
        p.VcT_s[((size_t)(b * 4 + hd) * 128 + dv) * 4352 + pos] = f2bf(v[k]); }
    }
  }
}

DI void phase_p1(const Params& p, int l, char* smem, int bid, int nb, int vbid, int vnb) {
  for (int it = vbid; it < 128; it += vnb) ctx_item(p, l, it);
  const int ntiles = 48 * 19;
  bool pre = false;
  for (int k = 0;; ++k) {
    const int it = xcd_tile(k, bid, nb);
    if (k * nb >= ntiles) break;
    if (it >= ntiles) continue;
    int mt, nt; tile_mn(it, 48, 19, mt, nt);
    const int it2 = xcd_tile(k + 1, bid, nb);
    const bool has_next = ((k + 1) * nb < ntiles) && (it2 < ntiles);
    int mt2 = 0, nt2 = 0; if (has_next) tile_mn(it2, 48, 19, mt2, nt2);
    const GemmNext nx{p.h, 1024, p.WinT, 1024, nt2 < 18 ? nt2 * 256 : 7680, 64, 4, mt2 * 256};
    f32x4 acc[8][4]; zero_acc<8>(acc);
    if (pre) { if (has_next) gemm_main<8, false, 4, true, true>(acc, p.h, 1024, mt * 256, NTOK - 1, p.WinT, 1024, nt < 18 ? nt * 256 : 7680, 1024, smem, 64, nx);
               else gemm_main<8, false, 4, true, false>(acc, p.h, 1024, mt * 256, NTOK - 1, p.WinT, 1024, nt < 18 ? nt * 256 : 7680, 1024, smem); }
    else     { if (has_next) gemm_main<8, false, 4, false, true>(acc, p.h, 1024, mt * 256, NTOK - 1, p.WinT, 1024, nt < 18 ? nt * 256 : 7680, 1024, smem, 64, nx);
               else gemm_main<8, false, 4, false, false>(acc, p.h, 1024, mt * 256, NTOK - 1, p.WinT, 1024, nt < 18 ? nt * 256 : 7680, 1024, smem); }
    pre = has_next;
    epi_p1(p, l, acc, mt * 256, nt);
  }
}

struct ChunkItem { int mixer, seq, chunk, h, tok0, sample, bidx; };
DI ChunkItem chunk_item(int it) {
  ChunkItem c; c.mixer = it / 768; int i = it % 768;
  if (i < 512) { c.sample = 1; int s = i >> 6; c.seq = 64 + s; c.chunk = i & 63; c.bidx = s >> 2; c.h = s & 3; c.tok0 = 4096 + c.bidx * 4096 + c.chunk * 64; }
  else { int j = i - 512; c.sample = 0; int s = j >> 2; c.seq = s; c.chunk = j & 3; c.bidx = s >> 2; c.h = s & 3; c.tok0 = c.bidx * 256 + c.chunk * 64; }
  return c;
}
DI size_t scan_off(const ChunkItem& c, int dir) {
  return (size_t)c.mixer * SCAN_MIX_ELEMS + (c.sample ? SCAN_SAMPLE_OFF + ((size_t)((c.seq - 64) * 2 + dir) * 64 + c.chunk) * 8192
                                                       : ((size_t)(c.seq * 2 + dir) * 4 + c.chunk) * 8192);
}
DI int dec_off(const ChunkItem& c, int dir) {
  return c.mixer * DEC_MIX + (c.sample ? DEC_SAMPLE_OFF + (((c.seq - 64) * 2 + dir) * 64 + c.chunk) * 64 : ((c.seq * 2 + dir) * 4 + c.chunk) * 64);
}

DI void compute_cum(const Params& p, int l, const ChunkItem& c, int e, float* sCum, float* sTot, float* sR) {
  const int tid = tidx();
  if (c.mixer == 0) {
    const float lg = logsigf_(p.ret_decay[(l * 2 + e) * 4 + c.h]);
    for (int idx = tid; idx < 4096; idx += 256) { int i = idx >> 6; sCum[idx] = (e == 0 ? (float)(i + 1) : (float)(64 - i)) * lg; }
    __syncthreads();
    return;
  }
  const int dk = tid & 63, qq = tid >> 6;
  const float* wa2 = p.gla_wa2 + ((size_t)(l * 2 + e) * 16) * 256 + c.h * 64 + dk;
  float w[16];
#pragma unroll
  for (int r = 0; r < 16; ++r) w[r] = wa2[r * 256];
  const float ba = p.gla_ba[(l * 2 + e) * 256 + c.h * 64 + dk];
  *reinterpret_cast<f32x4*>(sR + tid * 4) = *(const GAS f32x4*)(p.r + (size_t)(c.tok0 + (tid >> 2)) * 32 + e * 16 + (tid & 3) * 4);
  __syncthreads();
  float run = 0.f;
#pragma unroll 4
  for (int s = 0; s < 16; ++s) {
    const int i = e == 0 ? qq * 16 + s : qq * 16 + 15 - s;
    const float4* rp = reinterpret_cast<const float4*>(sR + i * 16);
    float4 r0 = rp[0], r1 = rp[1], r2 = rp[2], r3 = rp[3];
    float z = ba + r0.x * w[0] + r0.y * w[1] + r0.z * w[2] + r0.w * w[3] + r1.x * w[4] + r1.y * w[5] + r1.z * w[6] + r1.w * w[7]
                 + r2.x * w[8] + r2.y * w[9] + r2.z * w[10] + r2.w * w[11] + r3.x * w[12] + r3.y * w[13] + r3.z * w[14] + r3.w * w[15];
    run += logsigf_(z) * 0.0625f;
    sCum[i * 64 + dk] = run;
  }
  sTot[qq * 64 + dk] = run;
  __syncthreads();
  float off = 0.f;
  for (int g = 0; g < 4; ++g) if (e == 0 ? g < qq : g > qq) off += sTot[g * 64 + dk];
#pragma unroll 4
  for (int s = 0; s < 16; ++s) sCum[(qq * 16 + s) * 64 + dk] += off;
  __syncthreads();
}

DI void load_vt(const Params& p, const ChunkItem& c, u16* sVT) {
  const int tid = tidx();
  const int vcol = (c.mixer == 0 ? 512 : 2048) + c.h * 128;
#pragma unroll
  for (int it = 0; it < 4; ++it) {
    int ch = tid + 256 * it; int i = ch & 63, dvc = ch >> 6;
    uint4 v = *reinterpret_cast<const uint4*>(p.proj + (size_t)(c.tok0 + i) * PLD + vcol + dvc * 8);
    const u16* e = reinterpret_cast<const u16*>(&v);
#pragma unroll
    for (int k = 0; k < 8; ++k) sVT[(dvc * 8 + k) * 72 + i] = e[k];
  }
}

DI void p2a_item(const Params& p, int l, int it, char* smem) {
  const ChunkItem c = chunk_item(it);
  float* sCum = reinterpret_cast<float*>(smem);
  float* sTot = reinterpret_cast<float*>(smem + 16384);
  u16* sVT = reinterpret_cast<u16*>(smem + 17408);
  u16* sKT = reinterpret_cast<u16*>(smem + 35840);
  const int tid = tidx(), lane = tid & 63, wid = tid >> 6, lr16 = lane & 15, q = lane >> 4;
  const int kcol = (c.mixer == 0 ? 256 : 1792) + c.h * 64;
  u32x4 kreg0, kreg1;
  {
    gcu16p pg = (gcu16p)p.proj;
    kreg0 = *(gcu4p)(pg + (size_t)(c.tok0 + (tid & 63)) * PLD + kcol + (tid >> 6) * 8);
    kreg1 = *(gcu4p)(pg + (size_t)(c.tok0 + (tid & 63)) * PLD + kcol + ((tid >> 6) + 4) * 8);
  }
  load_vt(p, c, sVT);
  for (int e = 0; e < 2; ++e) {
    compute_cum(p, l, c, e, sCum, sTot, reinterpret_cast<float*>(smem + 45056));
    const int iref = e == 0 ? 63 : 0;
#define P2A_KT(kr_, dkc_) do { const int i = tid & 63; \
      _Pragma("unroll") for (int k = 0; k < 4; ++k) { \
        const int dk = (dkc_) * 8 + 2 * k; \
        sKT[dk * 72 + i] = f2bf(__uint_as_float(kr_[k] << 16) * __expf(sCum[iref * 64 + dk] - sCum[i * 64 + dk])); \
        sKT[(dk + 1) * 72 + i] = f2bf(__uint_as_float(kr_[k] & 0xffff0000u) * __expf(sCum[iref * 64 + dk + 1] - sCum[i * 64 + dk + 1])); } } while (0)
    P2A_KT(kreg0, (tid >> 6)); P2A_KT(kreg1, (tid >> 6) + 4);
    if (tid < 64) p.dec[dec_off(c, e) + tid] = __expf(sCum[iref * 64 + tid]);
    __syncthreads();
    f32x4 acc[2][4];
#pragma unroll
    for (int mi = 0; mi < 2; ++mi)
#pragma unroll
      for (int ni = 0; ni < 4; ++ni) acc[mi][ni] = zero4();
#pragma unroll
    for (int ks = 0; ks < 2; ++ks) {
      bf16x8 af[2], bfr[4];
#pragma unroll
      for (int mi = 0; mi < 2; ++mi) af[mi] = *reinterpret_cast<const bf16x8*>(sVT + (wid * 32 + mi * 16 + lr16) * 72 + ks * 32 + q * 8);
#pragma unroll
      for (int ni = 0; ni < 4; ++ni) bfr[ni] = *reinterpret_cast<const bf16x8*>(sKT + (ni * 16 + lr16) * 72 + ks * 32 + q * 8);
#pragma unroll
      for (int mi = 0; mi < 2; ++mi)
#pragma unroll
        for (int ni = 0; ni < 4; ++ni) acc[mi][ni] = MFMA16P(af[mi], bfr[ni], acc[mi][ni]);
    }
    u16* dst = p.scan + scan_off(c, e);
#pragma unroll
    for (int mi = 0; mi < 2; ++mi)
#pragma unroll
      for (int ni = 0; ni < 4; ++ni)
#pragma unroll
        for (int j = 0; j < 4; ++j) dst[(wid * 32 + mi * 16 + q * 4 + j) * 64 + ni * 16 + lr16] = f2bf(acc[mi][ni][j]);
    __syncthreads();
  }
}

template <int NCH>
DI void scan_unit(const Params& p, int l, int mixer, int seq, int dir, int eb, int sample) {
  const int el = eb * 256 + tidx(); const int dv = el >> 6, dk = el & 63;
  const int bidx = sample ? (seq - 64) >> 2 : seq >> 2; const int h = seq & 3;
  u16* buf = p.scan + (size_t)mixer * SCAN_MIX_ELEMS + (sample ? SCAN_SAMPLE_OFF + (size_t)((seq - 64) * 2 + dir) * 64 * 8192 : (size_t)(seq * 2 + dir) * 4 * 8192) + el;
  const float* dc = p.dec + mixer * DEC_MIX + (sample ? DEC_SAMPLE_OFF + ((seq - 64) * 2 + dir) * 64 * 64 : (seq * 2 + dir) * 4 * 64) + dk;
  float s = 0.f;
  if (sample) { const float* st = mixer == 0 ? p.state_ret : p.state_gla; s = st[((size_t)((bidx * 2 + l) * 2 + dir) * 4 + h) * 8192 + dk * 128 + dv]; }
  constexpr int BT = NCH < 16 ? NCH : 16;
  for (int n0 = 0; n0 < NCH; n0 += BT) {
    float d[BT], g[BT];
#pragma unroll
    for (int k = 0; k < BT; ++k) { int n = dir == 0 ? n0 + k : NCH - 1 - n0 - k; d[k] = bf2f(buf[(size_t)n * 8192]); g[k] = dc[n * 64]; }
#pragma unroll
    for (int k = 0; k < BT; ++k) { int n = dir == 0 ? n0 + k : NCH - 1 - n0 - k; buf[(size_t)n * 8192] = f2bf(s); s = g[k] * s + d[k]; }
  }
  if (!sample) { float* o = p.out + (mixer == 0 ? OUT_SRET : OUT_SGLA); o[((size_t)((bidx * 2 + l) * 2 + dir) * 4 + h) * 8192 + dk * 128 + dv] = s; }
}
DI void scan_quad(const Params& p, int l, int mixer, int seq, int dir, int eb0) {
  const int tid = tidx(); const int dk = tid & 63;
  const int bidx = seq >> 2, h = seq & 3;
  u16* buf = p.scan + (size_t)mixer * SCAN_MIX_ELEMS + (size_t)(seq * 2 + dir) * 4 * 8192 + eb0 * 256 + tid;
  const float* dc = p.dec + mixer * DEC_MIX + (seq * 2 + dir) * 4 * 64 + dk;
  float d[4][4], g[4];
#pragma unroll
  for (int k = 0; k < 4; ++k) { const int n = dir == 0 ? k : 3 - k; g[k] = dc[n * 64];
#pragma unroll
    for (int q = 0; q < 4; ++q) d[q][k] = bf2f(buf[(size_t)n * 8192 + q * 256]); }
  float s[4] = {0.f, 0.f, 0.f, 0.f};
#pragma unroll
  for (int k = 0; k < 4; ++k) { const int n = dir == 0 ? k : 3 - k;
#pragma unroll
    for (int q = 0; q < 4; ++q) { buf[(size_t)n * 8192 + q * 256] = f2bf(s[q]); s[q] = g[k] * s[q] + d[q][k]; } }
  float* o = p.out + (mixer == 0 ? OUT_SRET : OUT_SGLA) + ((size_t)((bidx * 2 + l) * 2 + dir) * 4 + h) * 8192;
#pragma unroll
  for (int q = 0; q < 4; ++q) { const int el = (eb0 + q) * 256 + tid; o[(el & 63) * 128 + (el >> 6)] = s[q]; }
}
DI void phase_p2b(const Params& p, int l, int bid, int nb) {
  for (int u = bid; u < 1024 + 2048; u += nb) {
    if (u < 1024) { int mixer = u >> 9, rem = u & 511; scan_unit<64>(p, l, mixer, 64 + (rem >> 6), (rem >> 5) & 1, rem & 31, 1); }
    else { int v = u - 1024; int mixer = v >> 10, rem = v & 1023; scan_quad(p, l, mixer, rem >> 4, (rem >> 3) & 1, (rem & 7) * 4); }
  }
}

DI void p2c_mix_item(const Params& p, int l, int it, char* smem) {
  const ChunkItem c = chunk_item(it);
  u16* sQf = reinterpret_cast<u16*>(smem);
  u16* sQb = reinterpret_cast<u16*>(smem + 9216);
  u16* sKf = reinterpret_cast<u16*>(smem + 18432);
  u16* sKb = reinterpret_cast<u16*>(smem + 27648);
  float* sCum = reinterpret_cast<float*>(smem + 36864);
  u16* sVT = reinterpret_cast<u16*>(smem + 36864);
  u16* sP = reinterpret_cast<u16*>(smem + 55296);
  float* sTot = reinterpret_cast<float*>(smem + 64512);
  const int tid = tidx(), lane = tid & 63, wid = tid >> 6, lr16 = lane & 15, q = lane >> 4;
  const int qcol = (c.mixer == 0 ? 0 : 1536) + c.h * 64, kcol = (c.mixer == 0 ? 256 : 1792) + c.h * 64;
  u32x4 qv0, qv1, kv0, kv1, vv0, vv1, vv2, vv3;
  {
    gcu16p pg = (gcu16p)p.proj;
    const int i0 = tid >> 3, dkc = tid & 7;
    qv0 = *(gcu4p)(pg + (size_t)(c.tok0 + i0) * PLD + dkc * 8 + qcol); qv1 = *(gcu4p)(pg + (size_t)(c.tok0 + i0 + 32) * PLD + dkc * 8 + qcol);
    kv0 = *(gcu4p)(pg + (size_t)(c.tok0 + i0) * PLD + dkc * 8 + kcol); kv1 = *(gcu4p)(pg + (size_t)(c.tok0 + i0 + 32) * PLD + dkc * 8 + kcol);
    const int vcol = (c.mixer == 0 ? 512 : 2048) + c.h * 128; const int vi = tid & 63, dvc = tid >> 6;
    vv0 = *(gcu4p)(pg + (size_t)(c.tok0 + vi) * PLD + vcol + dvc * 8); vv1 = *(gcu4p)(pg + (size_t)(c.tok0 + vi) * PLD + vcol + (dvc + 4) * 8);
    vv2 = *(gcu4p)(pg + (size_t)(c.tok0 + vi) * PLD + vcol + (dvc + 8) * 8); vv3 = *(gcu4p)(pg + (size_t)(c.tok0 + vi) * PLD + vcol + (dvc + 12) * 8);
  }
  bf16x8 stf[2][8], stb[2][8];
  {
    typedef const GAS bf16x8* gfrag;
    gcu16p STf = (gcu16p)p.scan + scan_off(c, 0);
    gcu16p STb = (gcu16p)p.scan + scan_off(c, 1);
    const int lr16_ = (tid & 63) & 15, q_ = (tid & 63) >> 4;
#pragma unroll
    for (int ks = 0; ks < 2; ++ks)
#pragma unroll
      for (int nd = 0; nd < 8; ++nd) {
        stf[ks][nd] = *(gfrag)(STf + (nd * 16 + lr16_) * 64 + ks * 32 + q_ * 8);
        stb[ks][nd] = *(gfrag)(STb + (nd * 16 + lr16_) * 64 + ks * 32 + q_ * 8);
      }
  }
#define MIX_BUILD(qv_, kv_, i_) do { const int dkc = tid & 7; \
      float cm[8]; _Pragma("unroll") for (int k = 0; k < 8; ++k) cm[k] = sCum[(i_) * 64 + dkc * 8 + k]; \
      u32x4 qo, ko; \
      _Pragma("unroll") for (int k = 0; k < 4; ++k) { \
        const float q0 = __uint_as_float(qv_[k] << 16), q1 = __uint_as_float(qv_[k] & 0xffff0000u); \
        const float k0 = __uint_as_float(kv_[k] << 16), k1 = __uint_as_float(kv_[k] & 0xffff0000u); \
        qo[k] = pack2(q0 * __expf(cm[2 * k]), q1 * __expf(cm[2 * k + 1])); \
        ko[k] = pack2(k0 * __expf(-cm[2 * k]), k1 * __expf(-cm[2 * k + 1])); } \
      *reinterpret_cast<u32x4*>(sQ + (i_) * 72 + dkc * 8) = qo; \
      *reinterpret_cast<u32x4*>(sK + (i_) * 72 + dkc * 8) = ko; } while (0)
  for (int e = 0; e < 2; ++e) {
    compute_cum(p, l, c, e, sCum, sTot, reinterpret_cast<float*>(smem + 55296));
    u16* sQ = e == 0 ? sQf : sQb; u16* sK = e == 0 ? sKf : sKb;
    MIX_BUILD(qv0, kv0, (tid >> 3));
    MIX_BUILD(qv1, kv1, (tid >> 3) + 32);
    __syncthreads();
  }
#define MIX_VT(vv_, dvc_) do { const int vi = tid & 63; \
      _Pragma("unroll") for (int k = 0; k < 4; ++k) { sVT[((dvc_) * 8 + 2 * k) * 72 + vi] = (u16)(vv_[k] & 0xffffu); sVT[((dvc_) * 8 + 2 * k + 1) * 72 + vi] = (u16)(vv_[k] >> 16); } } while (0)
  MIX_VT(vv0, (tid >> 6)); MIX_VT(vv1, (tid >> 6) + 4); MIX_VT(vv2, (tid >> 6) + 8); MIX_VT(vv3, (tid >> 6) + 12);
  const int irow = wid * 16;
  bf16x8 aQf[2], aQb[2];
#pragma unroll
  for (int ks = 0; ks < 2; ++ks) { aQf[ks] = *reinterpret_cast<const bf16x8*>(sQf + (irow + lr16) * 72 + ks * 32 + q * 8); aQb[ks] = *reinterpret_cast<const bf16x8*>(sQb + (irow + lr16) * 72 + ks * 32 + q * 8); }
#pragma unroll
  for (int nj = 0; nj < 4; ++nj) {
    f32x4 sf = zero4(), sb = zero4();
#pragma unroll
    for (int ks = 0; ks < 2; ++ks) {
      bf16x8 kf = *reinterpret_cast<const bf16x8*>(sKf + (nj * 16 + lr16) * 72 + ks * 32 + q * 8);
      bf16x8 kb = *reinterpret_cast<const bf16x8*>(sKb + (nj * 16 + lr16) * 72 + ks * 32 + q * 8);
      sf = MFMA16P(aQf[ks], kf, sf); sb = MFMA16P(aQb[ks], kb, sb);
    }
    const int jj = nj * 16 + lr16;
#pragma unroll
    for (int j = 0; j < 4; ++j) { int i = irow + q * 4 + j; float v = jj < i ? sf[j] : (jj > i ? sb[j] : sf[j] + sb[j]); sP[i * 72 + jj] = f2bf(v); }
  }
  __syncthreads();
  f32x4 o[8];
#pragma unroll
  for (int nd = 0; nd < 8; ++nd) o[nd] = zero4();
#pragma unroll
  for (int ks = 0; ks < 2; ++ks) {
    bf16x8 aP = *reinterpret_cast<const bf16x8*>(sP + (irow + lr16) * 72 + ks * 32 + q * 8);
#pragma unroll
    for (int nd = 0; nd < 8; ++nd) {
      bf16x8 vb = *reinterpret_cast<const bf16x8*>(sVT + (nd * 16 + lr16) * 72 + ks * 32 + q * 8);
      o[nd] = MFMA16P(aP, vb, o[nd]);
      o[nd] = MFMA16P(aQf[ks], stf[ks][nd], o[nd]);
      o[nd] = MFMA16P(aQb[ks], stb[ks][nd], o[nd]);
    }
  }
  const int gcol = (c.mixer == 0 ? 1024 : 2560) + c.h * 128, ycol = (c.mixer == 0 ? 512 : 2048) + c.h * 128;
  float gng[8];
#pragma unroll
  for (int nd = 0; nd < 8; ++nd) gng[nd] = c.mixer == 1 ? p.gla_norm_g[l * 128 + nd * 16 + lr16] : 1.f;
#pragma unroll
  for (int j = 0; j < 4; ++j) {
    float s = 0.f, ss = 0.f;
#pragma unroll
    for (int nd = 0; nd < 8; ++nd) { float v = o[nd][j]; s += v; ss += v * v; }
#pragma unroll
    for (int m = 1; m < 16; m <<= 1) { s += __shfl_xor(s, m); ss += __shfl_xor(ss, m); }
    const int tok = c.tok0 + irow + q * 4 + j;
    float mean, rstd;
    if (c.mixer == 0) { mean = s * (1.f / 128.f); float var = ss * (1.f / 128.f) - mean * mean; rstd = rsqrtf(fmaxf(var, 0.f) + EPS_F); }
    else { mean = 0.f; rstd = rsqrtf(ss * (1.f / 128.f) + EPS_F); }
    u16 gr[8];
#pragma unroll
    for (int nd = 0; nd < 8; ++nd) gr[nd] = ((const GAS u16*)p.proj)[(size_t)tok * PLD + gcol + nd * 16 + lr16];
#pragma unroll
    for (int nd = 0; nd < 8; ++nd) {
      const int dv = nd * 16 + lr16;
      float g = siluf_(bf2f(gr[nd]));
      float y = (o[nd][j] - mean) * rstd;
      if (c.mixer == 1) y *= gng[nd];
      p.proj[(size_t)tok * PLD + ycol + dv] = f2bf(y * g);
    }
  }
  __syncthreads();
}

DI void attn_item(const Params& p, int l, int it, char* smem) {
  int b, head, qb, Tk, tokbase;
  const u16 *Kc, *VcT;
  if (it < 256) { b = it >> 7; head = (it >> 5) & 3; qb = it & 31; Tk = 4352; tokbase = 4096 + b * 4096; Kc = p.Kc_s; VcT = p.VcT_s; }
  else { int j = it - 256; b = j >> 3; head = (j >> 1) & 3; qb = j & 1; Tk = 256; tokbase = b * 256; Kc = p.Kc_p; VcT = p.VcT_p; }
  const int tid = rtid(), lane = tid & 63, wid = tid >> 6, r = lane & 31, hh = lane >> 5;
  const int sub = wid >> 2, qrow0 = qb * 128 + 32 * (wid & 3);
  gcu16p K0 = (gcu16p)Kc + (size_t)(b * 8 + head * 2) * Tk * 64;
  gcu16p K1 = K0 + (size_t)Tk * 64;
  gcu16p VT = (gcu16p)VcT + (size_t)(b * 4 + head) * 128 * Tk;
  bf16x8 qf[4];
  {
    const u16* qp = p.proj + (size_t)(tokbase + qrow0 + r) * PLD + 3072 + (head * 2 + sub) * 64 + hh * 8;
#pragma unroll
    for (int ks = 0; ks < 4; ++ks) qf[ks] = *reinterpret_cast<const bf16x8*>(qp + ks * 16);
  }
  const int krow = tid >> 3, kch = tid & 7;
  const int ksw = (kch ^ ((krow >> 1) & 7)) << 4;
  u32x4 ak0, ak1, av0, av1, bk0, bk1, bv0, bv1;
#define ATT_GLOAD(P, t_) do { const int key0 = (t_) * 64; \
    P##k0 = *(gcu4p)(K0 + (size_t)(key0 + krow) * 64 + kch * 8); \
    P##k1 = *(gcu4p)(K1 + (size_t)(key0 + krow) * 64 + kch * 8); \
    P##v0 = *(gcu4p)(VT + (size_t)(krow) * Tk + key0 + kch * 8); \
    P##v1 = *(gcu4p)(VT + (size_t)(krow + 64) * Tk + key0 + kch * 8); } while (0)
#define ATT_VST(rv_, row_) do { const int f = ((row_) >> 1) & 15; \
      char* rowp = sbw + 16384 + (row_) * 128; \
      uint2 lo, hi; lo.x = rv_.x; lo.y = rv_.y; hi.x = rv_.z; hi.y = rv_.w; \
      *reinterpret_cast<uint2*>(rowp + (((2 * kch) ^ f) << 3)) = lo; \
      *reinterpret_cast<uint2*>(rowp + (((2 * kch + 1) ^ f) << 3)) = hi; } while (0)
#define ATT_SSTORE(P, sbw_) do { char* sbw = (sbw_); \
    *reinterpret_cast<u32x4*>(sbw + krow * 128 + ksw) = P##k0; \
    *reinterpret_cast<u32x4*>(sbw + 8192 + krow * 128 + ksw) = P##k1; \
    ATT_VST(P##v0, krow); ATT_VST(P##v1, krow + 64); } while (0)
  f32x16 oacc[4];
#pragma unroll
  for (int d = 0; d < 4; ++d)
#pragma unroll
    for (int i = 0; i < 16; ++i) oacc[d][i] = 0.f;
  float m_run = -1e30f, l_run = 0.f;
  const int nt = Tk >> 6;
  const int kswz = (r >> 1) & 7;
  const int vf = (r >> 1) & 15;
#define ATT_TILE(sb_) do { \
    const char* sK = (sb_) + sub * 8192; \
    const char* sV = (sb_) + 16384; \
    f32x16 st[2]; \
    _Pragma("unroll") for (int kb = 0; kb < 2; ++kb) { \
      _Pragma("unroll") for (int i = 0; i < 16; ++i) st[kb][i] = 0.f; \
      _Pragma("unroll") for (int ks = 0; ks < 4; ++ks) { \
        bf16x8 kf = *reinterpret_cast<const bf16x8*>(sK + (kb * 32 + r) * 128 + (((2 * ks + hh) ^ kswz) << 4)); \
        __builtin_amdgcn_s_setprio(1); \
        st[kb] = MFMA32(kf, qf[ks], st[kb]); \
        __builtin_amdgcn_s_setprio(0); } } \
    __builtin_amdgcn_sched_barrier(0); \
    float mx = st[0][0]; \
    _Pragma("unroll") for (int i = 1; i < 16; ++i) mx = fmaxf(mx, st[0][i]); \
    _Pragma("unroll") for (int i = 0; i < 16; ++i) mx = fmaxf(mx, st[1][i]); \
    mx = fmaxf(mx, __shfl_xor(mx, 32)); \
      \
    float alpha = 1.f; \
    if (!__all((mx - m_run) <= 8.f)) { \
      const float m_new = fmaxf(m_run, mx); \
      alpha = __builtin_amdgcn_exp2f(m_run - m_new); \
      m_run = m_new; \
      _Pragma("unroll") for (int d = 0; d < 4; ++d) \
        _Pragma("unroll") for (int i = 0; i < 16; ++i) oacc[d][i] *= alpha; \
    } \
    float ps = 0.f; \
    _Pragma("unroll") for (int kb = 0; kb < 2; ++kb) \
      _Pragma("unroll") for (int i = 0; i < 16; ++i) { float e = __builtin_amdgcn_exp2f(st[kb][i] - m_run); st[kb][i] = e; ps += e; } \
    l_run = l_run * alpha + ps; \
    __builtin_amdgcn_sched_barrier(0); \
    _Pragma("unroll") for (int kb = 0; kb < 2; ++kb) \
      _Pragma("unroll") for (int s2 = 0; s2 < 2; ++s2) { \
        union { bf16x8 v; unsigned u[4]; } pf; \
        pf.u[0] = pack2(st[kb][8 * s2 + 0], st[kb][8 * s2 + 1]); pf.u[1] = pack2(st[kb][8 * s2 + 2], st[kb][8 * s2 + 3]); \
        pf.u[2] = pack2(st[kb][8 * s2 + 4], st[kb][8 * s2 + 5]); pf.u[3] = pack2(st[kb][8 * s2 + 6], st[kb][8 * s2 + 7]); \
        const int u0 = 8 * kb + 4 * s2 + hh; \
        _Pragma("unroll") for (int d = 0; d < 4; ++d) { \
          const char* rowp = sV + (d * 32 + r) * 128; \
          union { bf16x8 v; uint2 h2[2]; } vfr; \
          vfr.h2[0] = *reinterpret_cast<const uint2*>(rowp + ((u0 ^ vf) << 3)); \
          vfr.h2[1] = *reinterpret_cast<const uint2*>(rowp + (((u0 + 2) ^ vf) << 3)); \
          __builtin_amdgcn_s_setprio(1); \
          oacc[d] = MFMA32(vfr.v, pf.v, oacc[d]); \
          __builtin_amdgcn_s_setprio(0); } \
        __builtin_amdgcn_sched_barrier(0); } } while (0)
#define ATT_BAR() asm volatile("s_waitcnt lgkmcnt(0)\n\ts_barrier" ::: "memory")
  ATT_GLOAD(a, 0);
  ATT_GLOAD(b, 1);
  ATT_SSTORE(a, smem);
  __syncthreads();
#pragma unroll 1
  for (int t = 0; t < nt; t += 2) {
    { int t2 = t + 2; t2 = t2 > nt - 1 ? nt - 1 : t2; ATT_GLOAD(a, t2); }
    ATT_TILE(smem);
    ATT_SSTORE(b, smem + 32768);
    ATT_BAR();
    { int t3 = t + 3; t3 = t3 > nt - 1 ? nt - 1 : t3; ATT_GLOAD(b, t3); }
    ATT_TILE(smem + 32768);
    ATT_SSTORE(a, smem);
    ATT_BAR();
  }
  __syncthreads();
  l_run += __shfl_xor(l_run, 32);
  const float inv = 1.f / l_run;
  float* sO = reinterpret_cast<float*>(smem);
  if (sub == 1) {
#pragma unroll
    for (int d = 0; d < 4; ++d)
#pragma unroll
      for (int i = 0; i < 16; ++i) { int dv = d * 32 + (i & 3) + 8 * (i >> 2) + 4 * hh; sO[((wid & 3) * 128 + dv) * 32 + r] = oacc[d][i] * inv; }
  }
  __syncthreads();
  if (sub == 0) {
    const float lam = p.lam[l * 2], li = p.lam[l * 2 + 1];
    float ss = 0.f;
#pragma unroll
    for (int d = 0; d < 4; ++d)
#pragma unroll
      for (int i = 0; i < 16; ++i) { int dv = d * 32 + (i & 3) + 8 * (i >> 2) + 4 * hh; float v = oacc[d][i] * inv - lam * sO[((wid & 3) * 128 + dv) * 32 + r]; oacc[d][i] = v; ss += v * v; }
    ss += __shfl_xor(ss, 32);
    const float sc = rsqrtf(ss * (1.f / 128.f) + EPS_F) * (1.f - li);
    u16* yp = p.proj + (size_t)(tokbase + qrow0 + r) * PLD + 3072 + head * 128;
    const float* gg = p.diff_subln_g + l * 128;
#pragma unroll
    for (int d = 0; d < 4; ++d)
#pragma unroll
      for (int g4 = 0; g4 < 4; ++g4) {
        const int dv = d * 32 + 8 * g4 + 4 * hh;
        uint2 o2; o2.x = pack2(oacc[d][4 * g4] * sc * gg[dv], oacc[d][4 * g4 + 1] * sc * gg[dv + 1]);
        o2.y = pack2(oacc[d][4 * g4 + 2] * sc * gg[dv + 2], oacc[d][4 * g4 + 3] * sc * gg[dv + 3]);
        *reinterpret_cast<uint2*>(yp + dv) = o2;
      }
  }
  __syncthreads();
}

DI void phase_p2a(const Params& p, int l, char* smem, int bid, int nb) { for (int it = bid; it < 1536; it += nb) p2a_item(p, l, it, smem); }
DI void phase_p2c(const Params& p, int l, char* smem_all, char* smem, int rbid, int rnb, int bid, int nb) {
  for (int it = rbid; it < 384; it += rnb) attn_item(p, l, it, smem_all);
  for (int it = bid; it < 1536; it += nb) p2c_mix_item(p, l, it, smem);
}

DI void phase_p3(const Params& p, int l, char* smem, int bid, int nb) {
  (void)l;
  u16* merged = p.scan;
  for (int k = 0;; ++k) {
    const int it = xcd_tile(k, bid, nb);
    if (k * nb >= 768) break;
    if (it >= 768) continue;
    int mt, nt; tile_mn(it, 48, 16, mt, nt);
    f32x4 sg[2][12]; zero_acc<2, 12>(sg);
    gemm_main<2, false, 12, false, true>(sg, p.h, 1024, mt * 256, NTOK - 1, p.WinT, 1024, 4608 + nt * 64, 1024, smem, 1024,
                                         GemmNext{p.proj + 512, PLD, p.WbT, 512, nt * 64, 64, 1, mt * 256});
    unsigned sgp[2][12][2];
#pragma unroll
    for (int a = 0; a < 2; ++a)
#pragma unroll
      for (int b = 0; b < 12; ++b) { sgp[a][b][0] = pack2(sigmoidf_(sg[a][b][0]), sigmoidf_(sg[a][b][1])); sgp[a][b][1] = pack2(sigmoidf_(sg[a][b][2]), sigmoidf_(sg[a][b][3])); __builtin_amdgcn_sched_barrier(0); }
    f32x4 tot[2][4]; zero_acc<2>(tot);
#pragma unroll
    for (int i = 0; i < 3; ++i) {
      f32x4 acc[2][4]; zero_acc<2>(acc);
      const int ycol = i == 0 ? 512 : (i == 1 ? 2048 : 3072);
      const int ycol2 = i == 0 ? 2048 : 3072;
      if (i < 2) gemm_main<2, false, 4, true, true>(acc, p.proj + ycol, PLD, mt * 256, NTOK - 1, p.WbT + (size_t)i * 1024 * 512, 512, nt * 64, 512, smem, 64,
                                                    GemmNext{p.proj + ycol2, PLD, p.WbT + (size_t)(i + 1) * 1024 * 512, 512, nt * 64, 64, 1, mt * 256});
      else gemm_main<2, false, 4, true, false>(acc, p.proj + ycol, PLD, mt * 256, NTOK - 1, p.WbT + (size_t)i * 1024 * 512, 512, nt * 64, 512, smem);
#pragma unroll
      for (int a = 0; a < 2; ++a)
#pragma unroll
        for (int b = 0; b < 4; ++b)
        {
          tot[a][b][0] += __uint_as_float(sgp[a][i * 4 + b][0] << 16) * acc[a][b][0];
          tot[a][b][1] += __uint_as_float(sgp[a][i * 4 + b][0] & 0xffff0000u) * acc[a][b][1];
          tot[a][b][2] += __uint_as_float(sgp[a][i * 4 + b][1] << 16) * acc[a][b][2];
          tot[a][b][3] += __uint_as_float(sgp[a][i * 4 + b][1] & 0xffff0000u) * acc[a][b][3];
        }
    }
    const int lane = rtid() & 63, wid = rtid() >> 6, lq = lane >> 4, lc = lane & 15;
#pragma unroll
    for (int a = 0; a < 2; ++a)
#pragma unroll
      for (int j = 0; j < 4; ++j) {
        const int tok = mt * 256 + wid * 32 + a * 16 + lq * 4 + j;
        u16* d = merged + (size_t)tok * 1024 + nt * 64 + lc;
        d[0] = f2bf(tot[a][0][j]); d[16] = f2bf(tot[a][1][j]); d[32] = f2bf(tot[a][2][j]); d[48] = f2bf(tot[a][3][j]);
      }
  }
}

#define PAN_WORD(c_, mt_) (3456 + ((c_) * 48 + (mt_)) * 64)
#define BAR_TOTAL_WORDS (3456 + 4 * 48 * 64)
DI void phase_res(const Params& p, int l, int which, char* smem, int bid, int nb) {
  const u16* A = which == 0 ? p.scan : p.proj; const int lda = which == 0 ? 1024 : 2816;
  const u16* B = which == 0 ? p.WoT : p.WdT; const int K = lda;
  const bool from_in = (l == 0 && which == 0);
  const bool has_next = (which == 0) || (l + 1 < 2);
  for (int it0 = bid; it0 < ((nb >> 3) * 8); it0 += nb) {
    const int per = 192 / 8, j = it0 >> 3;
    if (j >= per) {
      if (which == 1 && l == 0) {
        const int half = __builtin_amdgcn_readfirstlane((int)(threadIdx.x >> 8));
        const int vb = ((it0 & 7) + 8 * (j - per)) * 2 + half, vn = ((nb >> 3) - per) * 16;
        for (int ci = vb; ci < 1920; ci += vn) conv_item(p, 1, ci, smem + half * 65536);
      }
      continue;
    }
    const int it = (it0 & 7) * per + j;
    int mt, nt; tile_mn(it, 48, 4, mt, nt);
    f32x4 acc[8][4]; zero_acc<8>(acc);
    gemm_main<8, true>(acc, A, lda, mt * 256, NTOK - 1, B, K, nt * 256, K, smem);
    const int tid = rtid(), lane = tid & 63, wid = tid >> 6, wm = wid >> 2, wn = wid & 3, lq = lane >> 4, lc = lane & 15;
    const int row0 = mt * 256;
    const int cv = tok_cv(row0);
    const float* xt = from_in ? (row0 < 4096 ? p.x_prompt + (size_t)row0 * 1024 : p.x_sample + (size_t)(row0 - 4096) * 1024) : p.out + (size_t)row0 * 1024;
    const int cb = nt * 256 + wn * 64 + lq * 4;
    float* sRed = reinterpret_cast<float*>(smem);
    {
      const GAS f32x4* gm = (const GAS f32x4*)(p.mod + (l * 3 + cv) * 6144 + (which ? 5120 : 2048) + cb);
      f32x4 gv[4];
#pragma unroll
      for (int b = 0; b < 4; ++b) gv[b] = gm[b * 4];
#pragma unroll
      for (int a2 = 0; a2 < 4; ++a2) {
        int rloc = wm * 128 + a2 * 32 + lc;
        asm volatile("" : "+v"(rloc));
        f32x4 xv[2][4];
#pragma unroll
        for (int h2 = 0; h2 < 2; ++h2)
#pragma unroll
          for (int b = 0; b < 4; ++b) xv[h2][b] = *(const GAS f32x4*)(xt + (size_t)(rloc + h2 * 16) * 1024 + cb + b * 16);
#pragma unroll
        for (int h2 = 0; h2 < 2; ++h2) {
          const int a = a2 * 2 + h2;
          float s = 0.f, ss = 0.f;
#pragma unroll
          for (int b = 0; b < 4; ++b)
#pragma unroll
            for (int jj = 0; jj < 4; ++jj) { const float v = ALPHA_F * xv[h2][b][jj] + gv[b][jj] * acc[a][b][jj]; acc[a][b][jj] = v; s += v; ss += v * v; }
          s += __shfl_xor(s, 16); ss += __shfl_xor(ss, 16);
          s += __shfl_xor(s, 32); ss += __shfl_xor(ss, 32);
          if (lq == 0) { sRed[((rloc + h2 * 16) * 4 + wn) * 2] = s; sRed[((rloc + h2 * 16) * 4 + wn) * 2 + 1] = ss; }
        }
        __builtin_amdgcn_sched_barrier(0);
      }
    }
    __syncthreads();
    if (tid < 256) {
      const f32x4 u0 = *reinterpret_cast<const f32x4*>(sRed + tid * 8), u1 = *reinterpret_cast<const f32x4*>(sRed + tid * 8 + 4);
      float* sp = p.stats + ((size_t)(row0 + tid) * 4 + nt) * 2;
      sp[0] = u0[0] + u0[2] + u1[0] + u1[2]; sp[1] = u0[1] + u0[3] + u1[1] + u1[3];
    }
    asm volatile("s_waitcnt vmcnt(0)" ::: "memory");
    __syncthreads();
    if (tid == 0) {
      unsigned* cnt = p.bar + PAN_WORD(l * 2 + which, mt);
      __builtin_amdgcn_fence(__ATOMIC_RELEASE, "agent");
      asm volatile("s_waitcnt vmcnt(0)" ::: "memory");
      (void)__hip_atomic_fetch_add(cnt, 1u, __ATOMIC_RELAXED, __HIP_MEMORY_SCOPE_AGENT);
      unsigned sp_ = 0;
      while (__hip_atomic_load(cnt, __ATOMIC_RELAXED, __HIP_MEMORY_SCOPE_AGENT) < 4u && sp_ < (1u << 22)) { __builtin_amdgcn_s_sleep(1); ++sp_; }
      __builtin_amdgcn_fence(__ATOMIC_ACQUIRE, "agent");
      asm volatile("s_waitcnt vmcnt(0)" ::: "memory");
    }
    __syncthreads();
    {
      const float* lg = p.ln_g + (l * 2 + which) * 1024 + cb; const float* lb = p.ln_b + (l * 2 + which) * 1024 + cb;
      const float* md = (which == 0 ? p.mod + (l * 3 + cv) * 6144 + 3072 : p.mod + ((l + 1 < 2 ? l + 1 : l) * 3 + cv) * 6144) + cb;
#pragma unroll
      for (int a2 = 0; a2 < 4; ++a2) {
        int rloc = wm * 128 + a2 * 32 + lc;
        asm volatile("" : "+v"(rloc));
#pragma unroll
        for (int h2 = 0; h2 < 2; ++h2) {
          const int a = a2 * 2 + h2; const int row = row0 + rloc + h2 * 16;
          const f32x4 t0 = *(const GAS f32x4*)(p.stats + (size_t)row * 8), t1 = *(const GAS f32x4*)(p.stats + (size_t)row * 8 + 4);
          const float s = t0[0] + t0[2] + t1[0] + t1[2], ss = t0[1] + t0[3] + t1[1] + t1[3];
          const float mean = s * (1.f / 1024.f); const float var = fmaxf(ss * (1.f / 1024.f) - mean * mean, 0.f); const float rstd = rsqrtf(var + EPS_F);
#pragma unroll
          for (int b = 0; b < 4; ++b) {
            const f32x4 g4 = *(const GAS f32x4*)(lg + b * 16), b4 = *(const GAS f32x4*)(lb + b * 16);
            f32x4 x;
#pragma unroll
            for (int jj = 0; jj < 4; ++jj) x[jj] = (acc[a][b][jj] - mean) * rstd * g4[jj] + b4[jj];
            *(GAS f32x4*)(p.out + (size_t)row * 1024 + cb + b * 16) = x;
            if (has_next) {
              const f32x4 sh = *(const GAS f32x4*)(md + b * 16), sc = *(const GAS f32x4*)(md + 1024 + b * 16);
              uint2 o; o.x = pack2(x[0] * (1.f + sc[0]) + sh[0], x[1] * (1.f + sc[1]) + sh[1]); o.y = pack2(x[2] * (1.f + sc[2]) + sh[2], x[3] * (1.f + sc[3]) + sh[3]);
              *reinterpret_cast<uint2*>(p.h + (size_t)row * 1024 + cb + b * 16) = o;
            }
          }
        }
        __builtin_amdgcn_sched_barrier(0);
      }
    }
    __syncthreads();
  }
}

DI void phase_ln(const Params& p, int l, int which, char* smem, int bid, int nb) {
  const int lane = tidx() & 63, wid = tidx() >> 6;
  const bool has_next = (which == 0) || (l + 1 < 2);
  f32x4 gvv[4], bvv[4];
#pragma unroll
  for (int it = 0; it < 4; ++it) {
    gvv[it] = *(const GAS f32x4*)(p.ln_g + (l * 2 + which) * 1024 + it * 256 + lane * 4);
    bvv[it] = *(const GAS f32x4*)(p.ln_b + (l * 2 + which) * 1024 + it * 256 + lane * 4);
  }
  for (int row = bid * 4 + wid; row < NTOK; row += nb * 4) {
    float s = 0.f, ss = 0.f;
    if (lane < 16) { const float* sp = p.stats + ((size_t)row * 16 + lane) * 2; s = sp[0]; ss = sp[1]; }
    const float* md = which == 0 ? p.mod + (l * 3 + tok_cv(row)) * 6144 + 3072 : p.mod + ((l + 1 < 2 ? l + 1 : l) * 3 + tok_cv(row)) * 6144;
    float* xr = p.out + (size_t)row * 1024;
    f32x4 vin[4], shv[4], scv[4];
#pragma unroll
    for (int it = 0; it < 4; ++it) {
      vin[it] = *(const GAS f32x4*)(xr + it * 256 + lane * 4);
      shv[it] = *(const GAS f32x4*)(md + it * 256 + lane * 4);
      scv[it] = *(const GAS f32x4*)(md + 1024 + it * 256 + lane * 4);
    }
#pragma unroll
    for (int m = 1; m < 16; m <<= 1) { s += __shfl_xor(s, m); ss += __shfl_xor(ss, m); }
    s = __shfl(s, 0); ss = __shfl(ss, 0);
    const float mean = s * (1.f / 1024.f); const float var = fmaxf(ss * (1.f / 1024.f) - mean * mean, 0.f); const float rstd = rsqrtf(var + EPS_F);
#pragma unroll
    for (int it = 0; it < 4; ++it) {
      const int col = it * 256 + lane * 4;
      f32x4 v;
#pragma unroll
      for (int e = 0; e < 4; ++e) v[e] = (vin[it][e] - mean) * rstd * gvv[it][e] + bvv[it][e];
      *(GAS f32x4*)(xr + col) = v;
      if (has_next) {
        uint2 o; o.x = pack2(v[0] * (1.f + scv[it][0]) + shv[it][0], v[1] * (1.f + scv[it][1]) + shv[it][1]);
        o.y = pack2(v[2] * (1.f + scv[it][2]) + shv[it][2], v[3] * (1.f + scv[it][3]) + shv[it][3]);
        *reinterpret_cast<uint2*>(p.h + (size_t)row * 1024 + col) = o;
      }
    }
  }
  if (which == 1 && l == 0) {
    for (int it = bid; it < N_CONV_ITEMS; it += nb) conv_item(p, 1, it, smem);
  }
}

DI void phase_p5(const Params& p, int l, char* smem, int bid, int nb) {
  u16* U = p.proj;
  float* sA = reinterpret_cast<float*>(smem);
  const int ntiles = 49 * 22;
  for (int k = 0;; ++k) {
    const int it = xcd_tile(k, bid, nb);
    if (k * nb >= ntiles) break;
    if (it >= ntiles) continue;
    int mt, nt; tile_mn(it, 49, 22, mt, nt);
    const int g0 = mt * 254 - 1;
    f32x4 acc[8][4]; zero_acc<8>(acc);
    gemm_main<8>(acc, p.h, 1024, g0, NTOK - 1, p.WupT, 1024, nt * 256, 1024, smem);
    const int tid = rtid(), lane = tid & 63, wid = tid >> 6, wm = wid >> 2, wn = wid & 3, lq = lane >> 4, lc = lane & 15;
    float* sbase = sA + (wm * 128 + lq * 4) * 128 + (wn & 1) * 64 + lc;
    if (wn < 2) {
#pragma unroll
      for (int a = 0; a < 8; ++a)
#pragma unroll
        for (int b = 0; b < 4; ++b)
#pragma unroll
          for (int j = 0; j < 4; ++j) sbase[a * 2048 + j * 128 + b * 16] = acc[a][b][j];
    }
    __syncthreads();
    if (wn >= 2) {
      float w0[4], w1[4], w2[4], cbv[4];
#pragma unroll
      for (int b = 0; b < 4; ++b) { const int ch = nt * 128 + (wn - 2) * 64 + b * 16 + lc;
        w0[b] = p.ffn_conv_w[(l * 3 + 0) * 2816 + ch]; w1[b] = p.ffn_conv_w[(l * 3 + 1) * 2816 + ch]; w2[b] = p.ffn_conv_w[(l * 3 + 2) * 2816 + ch]; cbv[b] = p.ffn_conv_b[l * 2816 + ch]; }
      u16* ub = U + nt * 128 + (wn - 2) * 64 + lc;
#pragma unroll
      for (int a = 0; a < 8; ++a) {
#pragma unroll
        for (int j = 0; j < 4; ++j) {
          const int r = wm * 128 + a * 16 + lq * 4 + j; const int g = g0 + r;
          if (r >= 1 && r <= 254 && g < NTOK) {
            const bool st = g < 4096 ? ((g & 255) == 0) : ((g & 4095) == 0);
            const bool en = g < 4096 ? ((g & 255) == 255) : ((g & 4095) == 4095);
#pragma unroll
            for (int b = 0; b < 4; ++b) {
              const float* sp = sbase + a * 2048 + j * 128 + b * 16;
              const float ap = st ? 0.f : sp[-128];
              const float ac = sp[0];
              const float an = en ? 0.f : sp[128];
              const float cv = ap * w0[b] + ac * w1[b] + an * w2[b] + cbv[b];
              ub[(size_t)g * 2816 + b * 16] = f2bf(geluf_(cv) * acc[a][b][j]);
            }
          }
        }
        __builtin_amdgcn_sched_barrier(0);
      }
    }
    __syncthreads();
  }
}

DI void run_phase(int ph, char* smem_all, int rbid, int rnb) {
  const int half = __builtin_amdgcn_readfirstlane((int)(threadIdx.x >> 8));
  char* smem = smem_all + half * 65536; const int bid = rbid * 2 + half, nb = rnb * 2;
  unsigned long long ka = (unsigned long long)__builtin_amdgcn_kernarg_segment_ptr();
  asm volatile("" : "+s"(ka));
  const __attribute__((address_space(4))) Params& pk = *reinterpret_cast<const __attribute__((address_space(4))) Params*>(ka);
  Params p;
  p.x_prompt = (const float*)(const __attribute__((address_space(1))) float*)pk.x_prompt;
  p.x_sample = (const float*)(const __attribute__((address_space(1))) float*)pk.x_sample;
  p.cache_k = (const float*)(const __attribute__((address_space(1))) float*)pk.cache_k;
  p.cache_v = (const float*)(const __attribute__((address_space(1))) float*)pk.cache_v;
  p.state_ret = (const float*)(const __attribute__((address_space(1))) float*)pk.state_ret;
  p.state_gla = (const float*)(const __attribute__((address_space(1))) float*)pk.state_gla;
  p.c = (const float*)(const __attribute__((address_space(1))) float*)pk.c;
  p.c_ctx = (const float*)(const __attribute__((address_space(1))) float*)pk.c_ctx;
  p.ada_w = (const float*)(const __attribute__((address_space(1))) float*)pk.ada_w;
  p.ada_b = (const float*)(const __attribute__((address_space(1))) float*)pk.ada_b;
  p.w_in = (const float*)(const __attribute__((address_space(1))) float*)pk.w_in;
  p.ret_decay = (const float*)(const __attribute__((address_space(1))) float*)pk.ret_decay;
  p.gla_wa1 = (const float*)(const __attribute__((address_space(1))) float*)pk.gla_wa1;
  p.gla_wa2 = (const float*)(const __attribute__((address_space(1))) float*)pk.gla_wa2;
  p.gla_ba = (const float*)(const __attribute__((address_space(1))) float*)pk.gla_ba;
  p.gla_norm_g = (const float*)(const __attribute__((address_space(1))) float*)pk.gla_norm_g;
  p.diff_lam = (const float*)(const __attribute__((address_space(1))) float*)pk.diff_lam;
  p.diff_subln_g = (const float*)(const __attribute__((address_space(1))) float*)pk.diff_subln_g;
  p.w_branch = (const float*)(const __attribute__((address_space(1))) float*)pk.w_branch;
  p.w_out = (const float*)(const __attribute__((address_space(1))) float*)pk.w_out;
  p.ln_g = (const float*)(const __attribute__((address_space(1))) float*)pk.ln_g;
  p.ln_b = (const float*)(const __attribute__((address_space(1))) float*)pk.ln_b;
  p.ffn_w_up = (const float*)(const __attribute__((address_space(1))) float*)pk.ffn_w_up;
  p.ffn_conv_w = (const float*)(const __attribute__((address_space(1))) float*)pk.ffn_conv_w;
  p.ffn_conv_b = (const float*)(const __attribute__((address_space(1))) float*)pk.ffn_conv_b;
  p.ffn_w_down = (const float*)(const __attribute__((address_space(1))) float*)pk.ffn_w_down;
  p.out = (float*)(__attribute__((address_space(1))) float*)pk.out;
  p.dec = (float*)(__attribute__((address_space(1))) float*)pk.dec;
  p.r = (float*)(__attribute__((address_space(1))) float*)pk.r;
  p.stats = (float*)(__attribute__((address_space(1))) float*)pk.stats;
  p.mod = (float*)(__attribute__((address_space(1))) float*)pk.mod;
  p.rope = (float*)(__attribute__((address_space(1))) float*)pk.rope;
  p.lam = (float*)(__attribute__((address_space(1))) float*)pk.lam;
  p.WinT = (u16*)(__attribute__((address_space(1))) u16*)pk.WinT;
  p.WbT = (u16*)(__attribute__((address_space(1))) u16*)pk.WbT;
  p.WoT = (u16*)(__attribute__((address_space(1))) u16*)pk.WoT;
  p.WupT = (u16*)(__attribute__((address_space(1))) u16*)pk.WupT;
  p.WdT = (u16*)(__attribute__((address_space(1))) u16*)pk.WdT;
  p.proj = (u16*)(__attribute__((address_space(1))) u16*)pk.proj;
  p.Kc_p = (u16*)(__attribute__((address_space(1))) u16*)pk.Kc_p;
  p.VcT_p = (u16*)(__attribute__((address_space(1))) u16*)pk.VcT_p;
  p.Kc_s = (u16*)(__attribute__((address_space(1))) u16*)pk.Kc_s;
  p.VcT_s = (u16*)(__attribute__((address_space(1))) u16*)pk.VcT_s;
  p.h = (u16*)(__attribute__((address_space(1))) u16*)pk.h;
  p.scan = (u16*)(__attribute__((address_space(1))) u16*)pk.scan;
  p.bar = (unsigned*)(__attribute__((address_space(1))) unsigned*)pk.bar;
  if (ph == 0) { phase_pr0(p, smem, bid, nb); return; }
  if (ph == 1) { phase_pr1(p, bid, nb); return; }
  const int l = (ph - 2) / 10;
#ifdef ONLYS
  const int s = ONLYS;
#else
  const int s = (ph - 2) % 10;
#endif
  switch (s) {
    case 0: phase_p1(p, l, smem_all, rbid, rnb, bid, nb); break;
    case 1: phase_p2a(p, l, smem, bid, nb); break;
    case 2: phase_p2b(p, l, bid, nb); break;
    case 3: phase_p2c(p, l, smem_all, smem, rbid, rnb, bid, nb); break;
    case 4: phase_p3(p, l, smem_all, rbid, rnb); break;
    case 5: phase_res(p, l, 0, smem_all, rbid, rnb); break;
    case 6: break;
    case 7: phase_p5(p, l, smem_all, rbid, rnb); break;
    case 8: phase_res(p, l, 1, smem_all, rbid, rnb); break;
    default: if (l == 0) { for (int it = 1920 + bid; it < N_CONV_ITEMS; it += nb) conv_item(p, 1, it, smem); } break;
  }
}

#define XB_TMO      128
#define XB_XCNT(j)  (256  + 64 * (j))
#define XB_XSUB(j)  (1280 + 64 * (j))
#define XB_XGEN(j)  (2304 + 64 * (j))
#define XB_TOP      3328
#define XB_TOPGEN   3392
#define XCD_BAR_WORDS 3456
#define XB_SPIN_CAP (1u << 22)
#define LAS __attribute__((address_space(3)))
DI unsigned xb_ld(unsigned* p)              { return __hip_atomic_load(p, __ATOMIC_RELAXED, __HIP_MEMORY_SCOPE_AGENT); }
DI unsigned xb_add(unsigned* p, unsigned v) { return __hip_atomic_fetch_add(p, v, __ATOMIC_RELAXED, __HIP_MEMORY_SCOPE_AGENT); }
DI unsigned xb_xcc_id() { return (unsigned)__builtin_amdgcn_s_getreg((3 << 11) | 20) & 0xFu; }
#define XB_SPIN(cond, bar) do { unsigned _sp = 0; while (cond) { __builtin_amdgcn_s_sleep(1); \
    if ((++_sp & 255u) == 0u) { if (xb_ld(&(bar)[XB_TMO])) break; if (_sp > XB_SPIN_CAP) { atomicAdd(&(bar)[XB_TMO], 1u); break; } } } } while (0)
struct XcdBarrier { unsigned* bar; unsigned x; volatile LAS unsigned* st; };
DI XcdBarrier xcd_barrier_post(unsigned* bar, volatile LAS unsigned* st) {
  XcdBarrier b; b.bar = bar; b.x = xb_xcc_id(); b.st = st;
  if (threadIdx.x == 0) (void)xb_add(&bar[XB_XCNT(b.x)], 1u);
  return b;
}
DI void xcd_barrier_complete(unsigned* bar, unsigned x, unsigned& nloc, unsigned& nx) {
  const unsigned G = gridDim.x * gridDim.y * gridDim.z;
  unsigned sum, cnt, mine, sp = 0u;
  for (;;) {
    sum = 0u; cnt = 0u; mine = 0u;
#pragma unroll
    for (unsigned j = 0; j < 16; ++j) { const unsigned c = xb_ld(&bar[XB_XCNT(j)]); sum += c; cnt += (c > 0u) ? 1u : 0u; mine = (j == x) ? c : mine; }
    if (sum == G) break;
    __builtin_amdgcn_s_sleep(1);
    if ((++sp & 255u) == 0u) { if (xb_ld(&bar[XB_TMO])) break; if (sp > XB_SPIN_CAP) { atomicAdd(&bar[XB_TMO], 1u); break; } }
  }
  nloc = mine > 0u ? mine : 1u; nx = cnt > 0u ? cnt : 1u;
}
DI void xcd_barrier(const XcdBarrier& b) {
  asm volatile("s_waitcnt vmcnt(0)" ::: "memory");
  __syncthreads();
  if (threadIdx.x == 0) {
    unsigned* bar = b.bar;
    __builtin_amdgcn_s_waitcnt(0);
    unsigned nloc = b.st[0], nx = b.st[1];
    if (nloc == 0u) { xcd_barrier_complete(bar, b.x, nloc, nx); b.st[0] = nloc; b.st[1] = nx; }
    const unsigned old = xb_add(&bar[XB_XSUB(b.x)], 1u);
    const unsigned gen = old / nloc;
    if (old + 1u == (gen + 1u) * nloc) {
      __builtin_amdgcn_fence(__ATOMIC_RELEASE, "agent");
      asm volatile("s_waitcnt vmcnt(0)" ::: "memory");
      const unsigned og = xb_add(&bar[XB_TOP], 1u);
      const unsigned tg = og / nx;
      if (og + 1u == (tg + 1u) * nx) xb_add(&bar[XB_TOPGEN], 1u);
      else XB_SPIN(xb_ld(&bar[XB_TOPGEN]) == tg, bar);
      __builtin_amdgcn_fence(__ATOMIC_ACQUIRE, "agent");
      xb_add(&bar[XB_XGEN(b.x)], 1u);
      asm volatile("s_waitcnt vmcnt(0)" ::: "memory");
    } else {
      XB_SPIN(xb_ld(&bar[XB_XGEN(b.x)]) == gen, bar);
      __builtin_amdgcn_fence(__ATOMIC_ACQUIRE, "agent");
      asm volatile("s_waitcnt vmcnt(0)" ::: "memory");
    }
  }
  __syncthreads();
}

#define N_PHASES 22

__global__ void __launch_bounds__(512, 2) k_mega(Params p) {
  extern __shared__ __attribute__((aligned(16))) char smem[];
  __shared__ uint4 xb_words;
  cg::grid_group grid = cg::this_grid();
  if (threadIdx.x == 0) xb_words = make_uint4(0u, 0u, 0u, 0u);
  __syncthreads();
  XcdBarrier xb = xcd_barrier_post(p.bar, (volatile LAS unsigned*)&xb_words);
#define RUNPH(n_) do { int bid_ = blockIdx.x, nb_ = gridDim.x; asm volatile("" : "+s"(bid_), "+s"(nb_)); run_phase(n_, smem, bid_, nb_); } while (0)
#define GSYNC() xcd_barrier(xb)
  RUNPH(0); if (p.bar == nullptr) grid.sync(); else GSYNC(); RUNPH(1); GSYNC();
  RUNPH(2); GSYNC(); RUNPH(3); GSYNC(); RUNPH(4); GSYNC(); RUNPH(5); GSYNC(); RUNPH(6); GSYNC();
  RUNPH(7); GSYNC(); RUNPH(9); GSYNC(); RUNPH(10); GSYNC(); RUNPH(11); GSYNC();
  RUNPH(12); GSYNC(); RUNPH(13); GSYNC(); RUNPH(14); GSYNC(); RUNPH(15); GSYNC(); RUNPH(16); GSYNC();
  RUNPH(17); GSYNC(); RUNPH(19); GSYNC(); RUNPH(20);
}

extern "C" void kernel_launch(void* const* d_in, const int* in_sizes, int n_in, void* d_out, int out_size, void* d_ws, size_t ws_size, hipStream_t stream) {
  (void)in_sizes; (void)n_in; (void)out_size;
  Params p{};
  const float** f = reinterpret_cast<const float**>(&p);
  for (int i = 0; i < 26; ++i) f[i] = (const float*)d_in[i];
  p.out = (float*)d_out;
  char* w = (char*)d_ws; size_t off = 0;
  auto take = [&](size_t bytes) { char* r = w + off; off += (bytes + 255) & ~(size_t)255; return r; };
  p.WinT = (u16*)take((size_t)7936 * 1024 * 2);
  p.WbT = (u16*)take((size_t)3 * 1024 * 512 * 2);
  p.WoT = (u16*)take((size_t)1024 * 1024 * 2);
  p.WupT = (u16*)take((size_t)5632 * 1024 * 2);
  p.WdT = (u16*)take((size_t)1024 * 2816 * 2);
  p.proj = (u16*)take((size_t)NTOK * PLD * 2);
  p.Kc_p = (u16*)take((size_t)16 * 8 * 256 * 64 * 2);
  p.VcT_p = (u16*)take((size_t)16 * 4 * 128 * 256 * 2);
  p.Kc_s = (u16*)take((size_t)2 * 8 * 4352 * 64 * 2);
  p.VcT_s = (u16*)take((size_t)2 * 4 * 128 * 4352 * 2);
  p.h = (u16*)take((size_t)NTOK * 1024 * 2);
  p.scan = (u16*)take((size_t)2 * SCAN_MIX_ELEMS * 2);
  p.dec = (float*)take((size_t)2 * DEC_MIX * 4);
  p.r = (float*)take((size_t)NTOK * 32 * 4);
  p.stats = (float*)take((size_t)NTOK * 16 * 2 * 4);
  p.mod = (float*)take((size_t)2 * 3 * 6144 * 4);
  p.rope = (float*)take((size_t)64 * 16 * 2 * 4);
  p.lam = (float*)take(256);
  p.bar = (unsigned*)take((size_t)BAR_TOTAL_WORDS * 4);
  if (off > ws_size) { fprintf(stderr, "workspace too small: need %zu have %zu\n", off, ws_size); return; }
  constexpr size_t kDynLds = 131072;
  static int grid_blocks = 0;
  if (!grid_blocks) {
    int dev = 0, cus = 0, per_cu = 0;
    (void)hipGetDevice(&dev);
    (void)hipDeviceGetAttribute(&cus, hipDeviceAttributeMultiprocessorCount, dev);
    (void)hipFuncSetAttribute((const void*)k_mega, hipFuncAttributeMaxDynamicSharedMemorySize, (int)kDynLds);
    (void)hipOccupancyMaxActiveBlocksPerMultiprocessor(&per_cu, k_mega, 512, kDynLds);
    if (per_cu > 1) per_cu = 1;
    grid_blocks = cus * per_cu;
    grid_blocks &= ~7;
  }
  (void)hipMemsetAsync(p.bar, 0, (size_t)BAR_TOTAL_WORDS * 4, stream);
  void* args[] = {&p};
  hipError_t e = hipLaunchCooperativeKernel((void*)k_mega, dim3(grid_blocks), dim3(512), args, kDynLds, stream);
  if (e != hipSuccess) fprintf(stderr, "cooperative launch failed: %s (grid %d)\n", hipGetErrorString(e), grid_blocks);
}
```
